# Optimizing an MI355X kernel written in HIP

```python
import math
import jax, jax.numpy as jnp
from jax import lax
import numpy as np

D_MODEL = 1024
BATCH = 16
SEQ = 2048
DEPTH = 2

CTX_LEN = 256
GRID_W = 64
N_GROUPS = 4
GROUP_W = D_MODEL // N_GROUPS
N_SPLITS = 10
D_IN = N_SPLITS * GROUP_W
N_HEADS_A = 4
HEAD_A = GROUP_W // N_HEADS_A
CHUNK = 128
N_HEADS_B = 4
HEAD_V_B = GROUP_W // N_HEADS_B
HEAD_QK_B = HEAD_V_B // 2
Q_BLOCK = 128
ROPE_BASE = 10000.0
CONV_C = 31
CONV_D = 3
N_EXPERTS = 32
TOP_K = 4
D_FF = D_MODEL
SWIGLU_LIMIT = 7.0
SWIGLU_ALPHA = 1.702
EPS = 1e-6

kernel_name = "hybrid_headgroup_diffusion_moe"


def rms_norm(x, g):
    xf = x.astype(jnp.float32)
    y = xf * lax.rsqrt(jnp.mean(xf * xf, axis=-1, keepdims=True) + EPS)
    return (y * g.astype(jnp.float32)).astype(x.dtype)


def layer_norm(x, g, b):
    xf = x.astype(jnp.float32)
    mu = jnp.mean(xf, axis=-1, keepdims=True)
    var = jnp.mean(jnp.square(xf - mu), axis=-1, keepdims=True)
    y = (xf - mu) * lax.rsqrt(var + EPS) * g.astype(jnp.float32) + b.astype(jnp.float32)
    return y.astype(x.dtype)


def axial_rope_tables(n):
    rows = n // GRID_W
    row = jnp.repeat(jnp.arange(rows, dtype=jnp.float32), GRID_W)
    col = jnp.tile(jnp.arange(GRID_W, dtype=jnp.float32), rows)
    nf = HEAD_QK_B // 4
    inv = ROPE_BASE ** (-jnp.arange(nf, dtype=jnp.float32) / nf)
    ar = row[:, None] * inv
    ac = col[:, None] * inv
    return jnp.cos(ar), jnp.sin(ar), jnp.cos(ac), jnp.sin(ac)


def _rotate(x, cos, sin):
    h = x.shape[-1] // 2
    x1, x2 = x[..., :h], x[..., h:]
    return jnp.concatenate([x1 * cos - x2 * sin, x1 * sin + x2 * cos], axis=-1)


def apply_axial_rope(x, tables):
    cr, sr, cc, sc = [t[None, :, None, None, :] for t in tables]
    xf = x.astype(jnp.float32)
    half = x.shape[-1] // 2
    out = jnp.concatenate([_rotate(xf[..., :half], cr, sr), _rotate(xf[..., half:], cc, sc)], axis=-1)
    return out.astype(x.dtype)


def dwconv(x, w):
    k = w.shape[0]
    return lax.conv_general_dilated(x, w[:, None, :], (1,), [(k // 2, k // 2)],
                                    dimension_numbers=("NWC", "WIO", "NWC"),
                                    feature_group_count=x.shape[-1])


def chunk_gmlp(au, av, vnorm_g, w_s, b_s):
    bsz, n, _ = au.shape
    u = jax.nn.gelu(au)
    v = jax.nn.gelu(av).reshape(bsz, n // CHUNK, CHUNK, N_HEADS_A, HEAD_A)
    v = rms_norm(v, vnorm_g.reshape(N_HEADS_A, HEAD_A))
    mixed = jnp.einsum("hpq,bnqhc->bnphc", w_s, v) + b_s.T[:, :, None]
    return u * mixed.reshape(bsz, n, GROUP_W)


def qk_heads(t, g):
    bsz, n, _ = t.shape
    return rms_norm(t.reshape(bsz, n, N_HEADS_B, 2, HEAD_QK_B), g)


def v_heads(t):
    bsz, n, _ = t.shape
    return t.reshape(bsz, n, N_HEADS_B, HEAD_V_B)


def diff_attention(q, k, v, lam):
    s = jnp.einsum("bqhmd,bkhmd->bhmqk", q, k).astype(jnp.float32) * (q.shape[-1] ** -0.5)
    p = jax.nn.softmax(s, axis=-1)
    w = p[:, :, 0] - lam * p[:, :, 1]
    return jnp.einsum("bhqk,bkhe->bqhe", w.astype(v.dtype), v)


def diff_attention_blocks(q, k, v, lam):
    bsz, n = q.shape[:2]
    qb = q.reshape(bsz, n // Q_BLOCK, Q_BLOCK, *q.shape[2:]).swapaxes(0, 1)
    out = lax.map(lambda qq: diff_attention(qq, k, v, lam), qb)
    return out.swapaxes(0, 1).reshape(bsz, n, N_HEADS_B, HEAD_V_B)


def diff_post(y, g, lam_init):
    bsz, n = y.shape[:2]
    return (rms_norm(y, g) * (1.0 - lam_init)).reshape(bsz, n, GROUP_W)


def conformer_conv(ca, cg, w, b, ln_g, ln_b):
    z = ca * jax.nn.sigmoid(cg)
    z = dwconv(z, w) + b
    return jax.nn.silu(layer_norm(z, ln_g, ln_b))


def short_gated_conv(db, dc, dh, w):
    return db * dwconv(dc * dh, w)


def moe_ffn(t, w_r, b_r, w_gu, b_gu, w_dn, b_dn):
    logits = (t @ w_r + b_r).astype(jnp.float32)
    top_v, top_i = lax.top_k(logits, TOP_K)
    gates = jnp.einsum("nk,nke->ne", jax.nn.softmax(top_v, axis=-1),
                       jax.nn.one_hot(top_i, N_EXPERTS, dtype=jnp.float32))

    def expert(acc, xs):
        wgu, bgu, wdn, bdn, g = xs
        gl, up = jnp.split(t @ wgu + bgu, 2, axis=-1)
        gl = jnp.minimum(gl, SWIGLU_LIMIT)
        up = jnp.clip(up, -SWIGLU_LIMIT, SWIGLU_LIMIT)
        hid = (up + 1.0) * gl * jax.nn.sigmoid(SWIGLU_ALPHA * gl)
        return acc + g[:, None].astype(t.dtype) * (hid @ wdn + bdn), None

    out, _ = lax.scan(expert, jnp.zeros_like(t), (w_gu, b_gu, w_dn, b_dn, gates.T))
    return out


def setup_inputs(seed: int = 0) -> dict:
    key = jax.random.key(seed)
    ks = iter(jax.random.split(key, 40))

    def nrm(shape, scale):
        return jax.random.normal(next(ks), shape, jnp.float32) * scale

    L, D, G, E, F = DEPTH, D_MODEL, GROUP_W, N_EXPERTS, D_FF
    return {
        "x": nrm((BATCH, SEQ, D), 1.0),
        "c": nrm((BATCH, D), 1.0),
        "ctx": nrm((BATCH, CTX_LEN, D), 1.0),
        "c_ctx": nrm((D,), 1.0),
        "w_mod": nrm((L, D, 6 * D), 0.5 * D ** -0.5),
        "b_mod": nrm((L, 6 * D), 0.02),
        "norm1_g": 1.0 + nrm((L, D), 0.02),
        "norm2_g": 1.0 + nrm((L, D), 0.02),
        "w_in": nrm((L, D, D_IN), D ** -0.5),
        "a_vnorm_g": 1.0 + nrm((L, G), 0.02),
        "a_ws": nrm((L, N_HEADS_A, CHUNK, CHUNK), CHUNK ** -0.5),
        "a_bs": 1.0 + nrm((L, N_HEADS_A, CHUNK), 0.1),
        "b_qnorm_g": 1.0 + nrm((L, 2, HEAD_QK_B), 0.02),
        "b_knorm_g": 1.0 + nrm((L, 2, HEAD_QK_B), 0.02),
        "b_lam_q1": nrm((L, HEAD_QK_B), 0.1),
        "b_lam_k1": nrm((L, HEAD_QK_B), 0.1),
        "b_lam_q2": nrm((L, HEAD_QK_B), 0.1),
        "b_lam_k2": nrm((L, HEAD_QK_B), 0.1),
        "b_subln_g": 1.0 + nrm((L, HEAD_V_B), 0.02),
        "c_conv_w": nrm((L, CONV_C, G), CONV_C ** -0.5),
        "c_conv_b": nrm((L, G), 0.02),
        "c_ln_g": 1.0 + nrm((L, G), 0.02),
        "c_ln_b": nrm((L, G), 0.02),
        "d_conv_w": nrm((L, CONV_D, G), CONV_D ** -0.5),
        "w_out": nrm((L, D, D), D ** -0.5),
        "router_w": nrm((L, D, E), D ** -0.5),
        "router_b": nrm((L, E), 0.01),
        "exp_w_gu": nrm((L, E, D, 2 * F), D ** -0.5),
        "exp_b_gu": nrm((L, E, 2 * F), 0.01),
        "exp_w_dn": nrm((L, E, F, D), F ** -0.5),
        "exp_b_dn": nrm((L, E, D), 0.01),
    }


def reference(x, c, ctx, c_ctx, w_mod, b_mod, norm1_g, norm2_g, w_in, a_vnorm_g, a_ws, a_bs,
              b_qnorm_g, b_knorm_g, b_lam_q1, b_lam_k1, b_lam_q2, b_lam_k2, b_subln_g,
              c_conv_w, c_conv_b, c_ln_g, c_ln_b, d_conv_w, w_out, router_w, router_b,
              exp_w_gu, exp_b_gu, exp_w_dn, exp_b_dn):
    bsz, seq, dm = x.shape
    rope = axial_rope_tables(seq)
    xc = ctx
    for l in range(DEPTH):
        last = l == DEPTH - 1
        lam_init = 0.8 - 0.6 * math.exp(-0.3 * l)
        lam = (jnp.exp(jnp.sum(b_lam_q1[l] * b_lam_k1[l]).astype(jnp.float32))
               - jnp.exp(jnp.sum(b_lam_q2[l] * b_lam_k2[l]).astype(jnp.float32)) + lam_init)
        sh1, sc1, g1, sh2, sc2, g2 = jnp.split((jax.nn.silu(c) @ w_mod[l] + b_mod[l])[:, None, :], 6, axis=-1)
        sh1c, sc1c, g1c, sh2c, sc2c, g2c = jnp.split(jax.nn.silu(c_ctx) @ w_mod[l] + b_mod[l], 6)
        h = rms_norm(x, norm1_g[l]) * (1.0 + sc1) + sh1
        hc = rms_norm(xc, norm1_g[l]) * (1.0 + sc1c) + sh1c
        au, av, bq, bk, bv, ca, cg, db, dc, dh = jnp.split(h @ w_in[l], N_SPLITS, axis=-1)
        if last:
            bkc = hc @ w_in[l][:, 3 * GROUP_W:4 * GROUP_W]
            bvc = hc @ w_in[l][:, 4 * GROUP_W:5 * GROUP_W]
        else:
            auc, avc, bqc, bkc, bvc, cac, cgc, dbc, dcc, dhc = jnp.split(hc @ w_in[l], N_SPLITS, axis=-1)
        kc = qk_heads(bkc, b_knorm_g[l])
        vc = v_heads(bvc)
        q = apply_axial_rope(qk_heads(bq, b_qnorm_g[l]), rope)
        k = apply_axial_rope(qk_heads(bk, b_knorm_g[l]), rope)
        yb = diff_attention_blocks(q, jnp.concatenate([k, kc], axis=1),
                                   jnp.concatenate([v_heads(bv), vc], axis=1), lam)
        y = jnp.concatenate([
            chunk_gmlp(au, av, a_vnorm_g[l], a_ws[l], a_bs[l]),
            diff_post(yb, b_subln_g[l], lam_init),
            conformer_conv(ca, cg, c_conv_w[l], c_conv_b[l], c_ln_g[l], c_ln_b[l]),
            short_gated_conv(db, dc, dh, d_conv_w[l]),
        ], axis=-1)
        x = x + g1 * (y @ w_out[l])
        h2 = rms_norm(x, norm2_g[l]) * (1.0 + sc2) + sh2
        moe_args = (router_w[l], router_b[l], exp_w_gu[l], exp_b_gu[l], exp_w_dn[l], exp_b_dn[l])
        if last:
            x = x + g2 * moe_ffn(h2.reshape(-1, dm), *moe_args).reshape(x.shape)
        else:
            ycb = diff_attention(qk_heads(bqc, b_qnorm_g[l]), kc, vc, lam)
            yc = jnp.concatenate([
                chunk_gmlp(auc, avc, a_vnorm_g[l], a_ws[l], a_bs[l]),
                diff_post(ycb, b_subln_g[l], lam_init),
                conformer_conv(cac, cgc, c_conv_w[l], c_conv_b[l], c_ln_g[l], c_ln_b[l]),
                short_gated_conv(dbc, dcc, dhc, d_conv_w[l]),
            ], axis=-1)
            xc = xc + g1c * (yc @ w_out[l])
            h2c = rms_norm(xc, norm2_g[l]) * (1.0 + sc2c) + sh2c
            ff = moe_ffn(jnp.concatenate([h2.reshape(-1, dm), h2c.reshape(-1, dm)], axis=0), *moe_args)
            x = x + g2 * ff[:bsz * seq].reshape(x.shape)
            xc = xc + g2c * ff[bsz * seq:].reshape(xc.shape)
    return x
```

```cpp
#include <hip/hip_runtime.h>
#include <cstdio>
#include <cstdint>
#ifndef G1_FP8
#define G1_FP8 0
#endif
#ifndef G1_QLO
#define G1_QLO 0
#define G1_QHI 7
#endif
#ifndef MK_PER_PHASE
#define MK_PER_PHASE 0
#endif

typedef unsigned short bf16;
typedef float f32x4 __attribute__((ext_vector_type(4)));
typedef float f32x2 __attribute__((ext_vector_type(2)));
typedef unsigned u32x4 __attribute__((ext_vector_type(4)));
typedef unsigned u32x2 __attribute__((ext_vector_type(2)));
typedef short bf16x8_t __attribute__((ext_vector_type(8)));
typedef short v4i16_t __attribute__((ext_vector_type(4)));

constexpr int D = 1024, NB = 16, SEQ = 2048, NL = 2, CTXL = 256;
constexpr int NLAT = NB * SEQ, NCTX = NB * CTXL, NTOK = NLAT + NCTX;
constexpr int GW = 256, DIN = 2560, NE = 32, TOPK = 4, FF = 1024;
constexpr int DINP = 2048;
constexpr int NSLOT = NTOK * TOPK;
constexpr int HIDROWS = NSLOT + NE * 256;
constexpr int CAP = NTOK;
constexpr int NKEY = SEQ + CTXL;
constexpr float EPS = 1e-6f;
constexpr int NGRP = 2, GLAT = NLAT / NGRP, GCTX = NCTX / NGRP, GTOK = GLAT + GCTX, GCAP = GTOK, GHIDROWS = GTOK * TOPK + NE * 256;
struct Grp { int g, v, n, c, w; };
__device__ __forceinline__ int mk_lane() { int r; asm volatile("v_mbcnt_lo_u32_b32 %0, -1, 0\n\tv_mbcnt_hi_u32_b32 %0, -1, %0" : "=v"(r)); return r; }
#define MK_TID(grp) ((grp).w * 64 + mk_lane())
constexpr int MODW = 6 * D;

constexpr size_t MiB = 1u << 20;
constexpr size_t WS_CTL = 0, CTL_BYTES = 1 * MiB;
constexpr size_t WS_MOD = 1 * MiB;
constexpr size_t WS_X = 2 * MiB;
constexpr size_t WS_H = WS_X + 144 * MiB;
constexpr size_t WS_HQ = WS_X + 108 * MiB;
constexpr size_t WS_H8 = WS_X + 72 * MiB;
constexpr size_t WS_P = WS_H + 72 * MiB;
constexpr size_t WS_Y = WS_P + 180 * MiB;
constexpr size_t WS_HID = WS_Y + 72 * MiB;
constexpr size_t WS_O = WS_HID + 304 * MiB;
constexpr size_t WS_LIST = WS_O + 288 * MiB;
constexpr size_t WS_GATE = WS_LIST + 5 * MiB;
constexpr size_t WS_WIN = WS_GATE + 1 * MiB;
constexpr size_t WS_WOUT = WS_WIN + 10 * MiB;
constexpr size_t WS_WGU = WS_WOUT + 4 * MiB;
constexpr size_t WS_WDN = WS_WGU + 256 * MiB;
constexpr int DINQ = (G1_QHI - G1_QLO) * 256;
constexpr size_t WS_WINQ = WS_WDN + 128 * MiB;
constexpr size_t WS_VT = WS_WDN + 128 * MiB;
constexpr size_t WS_RWT = WS_VT + 20 * MiB;
constexpr size_t WS_SS = WS_RWT + 1 * MiB;
constexpr size_t WS_END = WS_SS + 3 * MiB;
constexpr int CW_CNT = 64;
constexpr int CW_BAR = 4096;
constexpr int CW_FLAG = 2048;

__device__ __forceinline__ float bf2f(bf16 v) { return __uint_as_float(((unsigned)v) << 16); }
__device__ __forceinline__ bf16 f2bf(float f) { unsigned u = __float_as_uint(f); return (bf16)((u + 0x7fffu + ((u >> 16) & 1u)) >> 16); }
__device__ __forceinline__ unsigned pk2(float lo, float hi) { return (unsigned)f2bf(lo) | ((unsigned)f2bf(hi) << 16); }
__device__ __forceinline__ float blo(unsigned w) { return __uint_as_float(w << 16); }
__device__ __forceinline__ float bhi(unsigned w) { return __uint_as_float(w & 0xffff0000u); }
__device__ __forceinline__ float sigmoid_f(float x) { return __builtin_amdgcn_rcpf(1.f + __builtin_amdgcn_exp2f(-1.44269504089f * x)); }
__device__ __forceinline__ float silu_f(float x) { return x * sigmoid_f(x); }
__device__ __forceinline__ float gelu_tanh(float x) { const float u = 0.7978845608f * (x + 0.044715f * x * x * x); return x * sigmoid_f(2.f * u); }
__device__ __forceinline__ int tok_modrow(int tok) { return tok < NLAT ? (tok >> 11) : 16; }
__device__ __forceinline__ int gtok(int g, int t) { return t < GLAT ? g * GLAT + t : NLAT + g * GCTX + (t - GLAT); }
__device__ __forceinline__ float wave_sum(float v) {
#pragma unroll
    for (int o = 1; o < 64; o <<= 1) v += __shfl_xor(v, o);
    return v;
}
__device__ __forceinline__ float wave_max(float v) {
#pragma unroll
    for (int o = 1; o < 64; o <<= 1) v = fmaxf(v, __shfl_xor(v, o));
    return v;
}
__device__ __forceinline__ float lam_init_of(int l) { return l == 0 ? 0.2f : 0.35550906f; }
#define LDS_WAIT() asm volatile("s_waitcnt lgkmcnt(0)" ::: "memory")
#define VM_WAIT() asm volatile("s_waitcnt vmcnt(0)" ::: "memory")

#define LAS __attribute__((address_space(3)))
#ifndef PG8_ALIGN_DEFAULT
#define PG8_ALIGN_DEFAULT true
#endif
namespace pg8 {
typedef short bf16x8 __attribute__((ext_vector_type(8)));
typedef int v4i_t __attribute__((ext_vector_type(4)));
typedef int v8i_t __attribute__((ext_vector_type(8)));
constexpr int BM = 256, BK = 64, HALF = 128, HTB = HALF * BK * 2, STAGE_BYTES = 8 * HTB;
__host__ __device__ __forceinline__ int lds_byte(int r, int c) { const int st = (r >> 4) * 2 + (c >> 5), rr = r & 15, cc = c & 31, ob = rr * 64 + cc * 2; return st * 1024 + (ob ^ (((ob >> 9) & 1) << 5)); }
__host__ __device__ __forceinline__ void stage_rc(int b, int& R, int& C) { const int st = b / 1024, sb = b % 1024, swz = sb ^ (((sb >> 9) & 1) << 5); R = (st >> 1) * 16 + swz / 64; C = (st & 1) * 32 + (swz % 64) / 2; }
__host__ __device__ __forceinline__ int perm32(int rho) { const int n = rho >> 4, i = rho & 15; return 8 * (i >> 2) + 4 * n + (i & 3); }
__device__ __forceinline__ void mfma_fp8(f32x4& acc, const v8i_t& b, const v8i_t& a, int sc) {
    asm volatile("v_mfma_scale_f32_16x16x128_f8f6f4 %0, %1, %2, %0, %3, %3 op_sel_hi:[0,0,0]" : "+v"(acc) : "v"(b), "v"(a), "v"(sc));
}
__device__ __forceinline__ void glds16_s(const void* sbase, unsigned voff, unsigned lds_dst) {
    unsigned keep;
    asm volatile("s_mov_b32 %0, m0\n\ts_mov_b32 m0, %3\n\ts_nop 0\n\tglobal_load_lds_dwordx4 %1, %2\n\ts_mov_b32 m0, %0" : "=&s"(keep) : "v"(voff), "s"(sbase), "s"(lds_dst) : "memory");
}
__device__ __forceinline__ unsigned cvt_pk_bf16(float lo, float hi) { unsigned r; asm volatile("v_cvt_pk_bf16_f32 %0, %1, %2" : "=v"(r) : "v"(lo), "v"(hi)); return r; }

struct GU { const char* a; const char* b; const int* rows; const LAS int* tab; int pm, pn, e, nvalid; };

template <class Epi, class Sched, bool GATHER, bool FP8 = false, int STAGGER = 0, bool ALIGN = PG8_ALIGN_DEFAULT>
__device__ __forceinline__ void gemm_phase(LAS unsigned char* lds, const int K, const Sched& S, const Epi& E, const int wv, LAS int* rowtab = nullptr) {
    int tid_ = wv * 64 + mk_lane(); asm volatile("" : "+v"(tid_));
    const int tid = tid_, wid = __builtin_amdgcn_readfirstlane(tid >> 6), lane = tid & 63, wr = wid >> 2, wc = wid & 3, fr = lane & 15, fq = lane >> 4;
    const int nt = K / BK;
    unsigned voffB[2];
#pragma unroll
    for (int i = 0; i < 2; ++i) { int R_, C_; stage_rc(tid * 16 + i * 8192, R_, C_); const int Rb = Epi::PERM ? ((R_ & ~31) + perm32(R_ & 31)) : R_; voffB[i] = (unsigned)(Rb * K + C_) * 2u; }
    const size_t kstep = (size_t)(BK * 2), hstep = (size_t)HALF * K * 2;
    const unsigned ldsb = (unsigned)__builtin_amdgcn_readfirstlane((int)(unsigned)(size_t)lds + wid * 1024);
    const int aoff = lds_byte(wr * 64 + fr, fq * 8), boff = lds_byte(wc * 32 + fr, fq * 8);
#define PG8_SA(b, h) (((b) * 2 + (h)) * HTB)
#define PG8_SB(b, h) ((4 + (b) * 2 + (h)) * HTB)
#define PG8_STAGE(bufoff, gbase, voff) do { _Pragma("unroll") for (int _i = 0; _i < 2; ++_i) \
        glds16_s((const void*)(gbase), (voff)[_i], ldsb + (unsigned)((bufoff) + _i * 8192)); } while (0)
#define PG8_LDA(dst, b, h) do { _Pragma("unroll") for (int m = 0; m < 4; ++m) dst[m] = __builtin_shufflevector(*(const LAS v4i_t*)(lds + PG8_SA(b, h) + aoff + m * 2048), *(const LAS v4i_t*)(lds + PG8_SA(b, h) + aoff + m * 2048 + 1024), 0, 1, 2, 3, 4, 5, 6, 7); } while (0)
#define PG8_LDB(dst, b, h) do { _Pragma("unroll") for (int n = 0; n < 2; ++n) dst[n] = __builtin_shufflevector(*(const LAS v4i_t*)(lds + PG8_SB(b, h) + boff + n * 2048), *(const LAS v4i_t*)(lds + PG8_SB(b, h) + boff + n * 2048 + 1024), 0, 1, 2, 3, 4, 5, 6, 7); } while (0)
#define PG8_MMA(ai, bj, At, Bt) do { __builtin_amdgcn_s_setprio(1); _Pragma("unroll") for (int m = 0; m < 4; ++m) _Pragma("unroll") for (int n = 0; n < 2; ++n) { \
        if (FP8) mfma_fp8(acc[ai][bj][m][n], Bt[n], At[m], sc8); \
        else { acc[ai][bj][m][n] = __builtin_amdgcn_mfma_f32_16x16x32_bf16(__builtin_bit_cast(bf16x8, __builtin_shufflevector(Bt[n], Bt[n], 0, 1, 2, 3)), __builtin_bit_cast(bf16x8, __builtin_shufflevector(At[m], At[m], 0, 1, 2, 3)), acc[ai][bj][m][n], 0, 0, 0); \
               acc[ai][bj][m][n] = __builtin_amdgcn_mfma_f32_16x16x32_bf16(__builtin_bit_cast(bf16x8, __builtin_shufflevector(Bt[n], Bt[n], 4, 5, 6, 7)), __builtin_bit_cast(bf16x8, __builtin_shufflevector(At[m], At[m], 4, 5, 6, 7)), acc[ai][bj][m][n], 0, 0, 0); } } __builtin_amdgcn_s_setprio(0); } while (0)
#define PG8_WAIT_V(n) asm volatile("s_waitcnt vmcnt(" #n ")" ::: "memory")
#define PG8_WAIT_L(n) asm volatile("s_waitcnt lgkmcnt(" #n ")" ::: "memory")
#define PG8_BAR __builtin_amdgcn_s_barrier()
#define PG8_SCHED __builtin_amdgcn_sched_barrier(0)
#define PG8_AOFF(dst, u) do { _Pragma("unroll") for (int _h = 0; _h < 2; ++_h) _Pragma("unroll") for (int _i = 0; _i < 2; ++_i) { int _R, _C; stage_rc(tid * 16 + _i * 8192, _R, _C); \
        if (GATHER) { int _r = _h * HALF + _R; _r = _r < (u).nvalid ? _r : (u).nvalid - 1; dst[_h][_i] = ((unsigned)((u).tab[_r] >> 2) * (unsigned)K + (unsigned)_C) * 2u; } \
        else dst[_h][_i] = (unsigned)(_R * K + _C) * 2u; } } while (0)
#define PG8_AH(h) (GATHER ? (size_t)0 : (size_t)(h) * hstep)
    GU cur, nxt; int ui = 0;
    if (!S.next(0, cur)) return;
    for (int s_ = 0; s_ < (S.c & 7) * STAGGER; ++s_) __builtin_amdgcn_s_sleep(56);
    f32x4 acc[2][2][4][2];
#pragma unroll
    for (int a = 0; a < 2; ++a)
#pragma unroll
        for (int b = 0; b < 2; ++b)
#pragma unroll
            for (int m = 0; m < 4; ++m)
#pragma unroll
                for (int n = 0; n < 2; ++n) acc[a][b][m][n] = (f32x4){0.f, 0.f, 0.f, 0.f};
    v8i_t At[4], B0[2], B1[2];
    typename Epi::Pre pre;
    int sc8 = 0x7f7f7f7f; asm volatile("" : "+v"(sc8));
    unsigned ao[2][2], an[2][2];
#define PG8_TABDMA(u, slot) do { if (rowtab != nullptr && wid == 0) glds16_s((const void*)(u).rows, (unsigned)mk_lane() * 16u, (unsigned)__builtin_amdgcn_readfirstlane((int)(unsigned)(size_t)(rowtab + (slot) * 256))); } while (0)
    cur.tab = rowtab; nxt.tab = rowtab;
    if (rowtab != nullptr) { PG8_TABDMA(cur, 0); PG8_WAIT_V(0); PG8_BAR; }
    PG8_AOFF(ao, cur);
    const char* cA = cur.a; const char* cB = cur.b;
    PG8_STAGE(PG8_SB(0, 0), cB, voffB); PG8_STAGE(PG8_SB(0, 1), cB + hstep, voffB); PG8_STAGE(PG8_SA(0, 0), cA, ao[0]); PG8_STAGE(PG8_SA(0, 1), cA + PG8_AH(1), ao[1]);
    if (wr == 1) PG8_BAR;
    PG8_WAIT_V(2); PG8_BAR;
    PG8_STAGE(PG8_SB(1, 0), cB + kstep, voffB); PG8_STAGE(PG8_SA(1, 0), cA + kstep, ao[0]); PG8_STAGE(PG8_SB(1, 1), cB + hstep + kstep, voffB);
    PG8_WAIT_V(6); PG8_BAR;
    for (;;) {
        const bool has_next = S.next(ui + 1, nxt);
        if (rowtab != nullptr) nxt.tab = rowtab + ((ui + 1) % 3) * 256;
        if (has_next) PG8_TABDMA(nxt, (ui + 1) % 3);
#pragma unroll
        for (int h = 0; h < 2; ++h)
#pragma unroll
            for (int i = 0; i < 2; ++i) an[h][i] = ao[h][i];
        const char* nA = has_next ? nxt.a : cA; const char* nB = has_next ? nxt.b : cB;
#pragma unroll 1
        for (int t = 0; t < nt; t += 2) {
            const bool last = (t == nt - 2);
            const char* a1 = cA + (size_t)(t + 1) * kstep;
            const char* a2 = last ? nA : cA + (size_t)(t + 2) * kstep; const char* b2 = last ? nB : cB + (size_t)(t + 2) * kstep;
            const char* a3 = a2 + kstep; const char* b3 = b2 + kstep;
            if (last) E.prefetch(pre, cur, wr, wc, fr, fq);
            if (GATHER && last && has_next) PG8_AOFF(an, nxt);
            unsigned o2[2][2];
#pragma unroll
            for (int h = 0; h < 2; ++h)
#pragma unroll
                for (int i = 0; i < 2; ++i) o2[h][i] = (GATHER && last) ? an[h][i] : ao[h][i];
            PG8_LDB(B0, 0, 0); PG8_LDB(B1, 0, 1); PG8_SCHED; PG8_LDA(At, 0, 0); PG8_STAGE(PG8_SA(1, 1), a1 + PG8_AH(1), ao[1]);
            PG8_WAIT_V(8); PG8_WAIT_L(0); PG8_BAR; PG8_MMA(0, 0, At, B0); PG8_MMA(0, 1, At, B1); PG8_BAR; PG8_SCHED;
            PG8_LDA(At, 0, 1); PG8_STAGE(PG8_SB(0, 0), b2, voffB); PG8_STAGE(PG8_SB(0, 1), b2 + hstep, voffB); PG8_STAGE(PG8_SA(0, 0), a2, o2[0]);
            PG8_WAIT_V(8); PG8_WAIT_L(0); PG8_BAR; if (!FP8 || cur.nvalid > HALF) { PG8_MMA(1, 0, At, B0); PG8_MMA(1, 1, At, B1); } PG8_BAR; PG8_SCHED;
            PG8_LDB(B0, 1, 0); PG8_LDB(B1, 1, 1); PG8_SCHED; PG8_LDA(At, 1, 0); PG8_STAGE(PG8_SA(0, 1), a2 + PG8_AH(1), o2[1]);
            PG8_WAIT_V(8); PG8_WAIT_L(0); PG8_BAR; PG8_MMA(0, 0, At, B0); PG8_MMA(0, 1, At, B1); PG8_BAR; PG8_SCHED;
            PG8_LDA(At, 1, 1); PG8_STAGE(PG8_SB(1, 0), b3, voffB); PG8_STAGE(PG8_SB(1, 1), b3 + hstep, voffB); PG8_STAGE(PG8_SA(1, 0), a3, o2[0]);
            PG8_WAIT_V(8); PG8_WAIT_L(0); PG8_BAR; if (!FP8 || cur.nvalid > HALF) { PG8_MMA(1, 0, At, B0); PG8_MMA(1, 1, At, B1); } PG8_BAR; PG8_SCHED;
        }
        if (ALIGN) { if (wr == 0) PG8_BAR; }
        if (FP8) asm volatile("s_nop 15\n\ts_nop 15" ::: "memory");
        E(acc, cur, wr, wc, fr, fq, pre);
        if (!has_next) break;
#pragma unroll
        for (int a = 0; a < 2; ++a)
#pragma unroll
            for (int b = 0; b < 2; ++b)
#pragma unroll
                for (int m = 0; m < 4; ++m)
#pragma unroll
                    for (int n = 0; n < 2; ++n) acc[a][b][m][n] = (f32x4){0.f, 0.f, 0.f, 0.f};
        cur = nxt; cA = nA; cB = nB; ++ui;
#pragma unroll
        for (int h = 0; h < 2; ++h)
#pragma unroll
            for (int i = 0; i < 2; ++i) ao[h][i] = an[h][i];
        if (ALIGN) { if (wr == 1) PG8_BAR; }
    }
    PG8_WAIT_V(0);
    if (!ALIGN) { if (wr == 0) PG8_BAR; }
    PG8_BAR;
#undef PG8_SA
#undef PG8_SB
#undef PG8_STAGE
#undef PG8_LDA
#undef PG8_LDB
#undef PG8_MMA
#undef PG8_WAIT_V
#undef PG8_WAIT_L
#undef PG8_BAR
#undef PG8_SCHED
#undef PG8_AOFF
#undef PG8_TABDMA
#undef PG8_AH
}

struct DenseOrder {
    const char* A; const char* Bt; int K, nM, nN, nwg, G, c, g;
    __device__ __forceinline__ void init(const bf16* A_, const bf16* Bt_, int M, int N, int K_, int G_, int c_, int g_) { A = (const char*)A_; Bt = (const char*)Bt_; K = K_; nM = M / BM; nN = N / BM; nwg = nM * nN; G = G_; c = c_; g = g_; }
    __device__ __forceinline__ bool next(int i, GU& u) const {
        const long L = (long)i * G + c; if (L >= nwg) return false;
        int wgid = (int)L; { const int q = nwg / 8, r = nwg % 8, xcd = wgid % 8, off = wgid / 8; wgid = (xcd < r ? xcd * (q + 1) : r * (q + 1) + (xcd - r) * q) + off; }
        const int nig = 8 * nN, gid = wgid / nig, fm = gid * 8, gsz = (nM - fm) < 8 ? (nM - fm) : 8;
        const int pml = fm + ((wgid % nig) % gsz); u.pm = pml < GLAT / BM ? g * (GLAT / BM) + pml : NLAT / BM + g * (GCTX / BM) + (pml - GLAT / BM);
        u.pn = (wgid % nig) / gsz; u.e = 0; u.nvalid = 256; u.rows = nullptr; u.tab = nullptr;
        u.a = A + (size_t)u.pm * BM * K * 2; u.b = Bt + (size_t)u.pn * BM * K * 2; return true;
    }
};
struct GroupOrder {
    const LAS int* tb; const LAS int* cn; const char* A; const char* Bt; const int* list; size_t bstride; int K, NT, G, c; bool gather;
    __device__ __forceinline__ bool next(int i, GU& u) const {
        const int T = __builtin_amdgcn_readfirstlane(tb[32]), per = G >> 3, x = c / per, j = c - x * per, tlo = (T * x) >> 3, thi = (T * (x + 1)) >> 3, q = i * per + j;
        if (q >= (thi - tlo) * NT) return false;
        int lane_ = mk_lane(); asm volatile("" : "+v"(lane_)); const int tile = tlo + q / NT, pn = q % NT, lane = lane_;
        const unsigned long long bal = __ballot(lane < 32 && tb[(lane & 31) + 1] <= tile);
        const int e = __builtin_amdgcn_readfirstlane(__builtin_popcountll(bal)), mt = tile - __builtin_amdgcn_readfirstlane(tb[e]);
        u.e = e; u.pm = mt; u.pn = pn; const int left = __builtin_amdgcn_readfirstlane(cn[e]) - mt * 256; u.nvalid = left < 256 ? left : 256; u.rows = list + (size_t)e * GCAP + mt * 256;
        u.b = Bt + (size_t)e * bstride + (size_t)pn * BM * K * 2;
        u.a = gather ? A : A + (size_t)tile * BM * K * 2;
        return true;
    }
};

template <bool F8, int PN0> struct EpiPT {
    static constexpr bool PERM = true; static constexpr float sc = F8 ? 1.f / 64.f : 1.f; bf16* P; const float* qg; long kdelta;
    __device__ __forceinline__ void qk_unit(const f32x4 (&acc)[2][2][4][2], const GU& u, int wr, int wc, int fr, int fq) const {
        const int row0 = u.pm * BM + wr * 64 + fr, cw = wc * 32 + 8 * fq, isq = (u.pn + PN0) == 2, odd = fq & 1;
        const bool lat = u.pm * BM < NLAT;
        const float* gp = qg + (isq ? 0L : kdelta) + (wc & 1) * 32 + 8 * fq;
        const f32x4 g0 = *(const f32x4*)gp, g1 = *(const f32x4*)(gp + 4);
        const float qs = isq ? 0.17677669529f * 1.44269504089f : 1.f;
#pragma unroll
        for (int ai = 0; ai < 2; ++ai)
#pragma unroll
            for (int m = 0; m < 4; ++m) {
                const int tok = row0 + ai * HALF + m * 16, s = tok & 2047; const float pos = (float)(fq < 2 ? (s >> 6) : (s & 63));
                float cs[8], sn[8];
#pragma unroll
                for (int j = 0; j < 8; ++j) { const float invj = j == 0 ? 1.f : j == 1 ? 0.316227766f : j == 2 ? 0.1f : j == 3 ? 0.0316227766f : j == 4 ? 0.01f : j == 5 ? 0.00316227766f : j == 6 ? 0.001f : 0.000316227766f; float rr = pos * invj * 0.15915494309f; rr -= rintf(rr); cs[j] = lat ? __builtin_amdgcn_cosf(rr) : 1.f; sn[j] = lat ? __builtin_amdgcn_sinf(rr) : 0.f; }
#pragma unroll
                for (int bj = 0; bj < 2; ++bj) {
                    float x[8]; float ss = 0.f;
#pragma unroll
                    for (int n = 0; n < 2; ++n)
#pragma unroll
                        for (int q = 0; q < 4; ++q) { x[4 * n + q] = acc[ai][bj][m][n][q] * sc; ss += x[4 * n + q] * x[4 * n + q]; }
                    ss += __shfl_xor(ss, 16); ss += __shfl_xor(ss, 32);
                    const float rstd = rsqrtf(ss * (1.f / 32.f) + EPS);
                    float o[8];
#pragma unroll
                    for (int j = 0; j < 8; ++j) { const float y = x[j] * rstd * (j < 4 ? g0[j & 3] : g1[j & 3]), p = __shfl_xor(y, 16); o[j] = (odd ? (p * sn[j] + y * cs[j]) : (y * cs[j] - p * sn[j])) * qs; }
                    u32x4 w; w.x = cvt_pk_bf16(o[0], o[1]); w.y = cvt_pk_bf16(o[2], o[3]); w.z = cvt_pk_bf16(o[4], o[5]); w.w = cvt_pk_bf16(o[6], o[7]);
                    *(u32x4*)(P + (size_t)tok * DINP + (u.pn + PN0) * BM + bj * HALF + cw) = w;
                }
            }
    }
    struct Pre {};
    __device__ __forceinline__ void prefetch(Pre&, const GU&, int, int, int, int) const {}
    __device__ __forceinline__ void operator()(const f32x4 (&acc)[2][2][4][2], const GU& u, int wr, int wc, int fr, int fq, const Pre&) const {
        if ((u.pn + PN0) == 2 || (u.pn + PN0) == 3) { qk_unit(acc, u, wr, wc, fr, fq); return; }
        const int row0 = u.pm * BM + wr * 64 + fr, cw = wc * 32 + 8 * fq;
        const int kind = ((u.pn + PN0) == 5 || (u.pn + PN0) == 6) ? 1 : (((u.pn + PN0) >= 8) ? 2 : 0);
        const int cbase = kind == 0 ? ((u.pn + PN0) < 5 ? (u.pn + PN0) * BM : 1536) : (kind == 1 ? 1280 + ((u.pn + PN0) - 5) * HALF : 1792 + ((u.pn + PN0) - 8) * HALF);
#pragma unroll
        for (int ai = 0; ai < 2; ++ai)
#pragma unroll
            for (int m = 0; m < 4; ++m) { bf16* rowp = P + (size_t)(row0 + ai * HALF + m * 16) * DINP + cbase + cw;
                if (kind == 0) {
#pragma unroll
                    for (int bj = 0; bj < 2; ++bj) { const f32x4 v0 = acc[ai][bj][m][0] * sc, v1 = acc[ai][bj][m][1] * sc;
                        u32x4 w; w.x = cvt_pk_bf16(v0[0], v0[1]); w.y = cvt_pk_bf16(v0[2], v0[3]); w.z = cvt_pk_bf16(v1[0], v1[1]); w.w = cvt_pk_bf16(v1[2], v1[3]);
                        *(u32x4*)(rowp + bj * HALF) = w; }
                } else {
                    float o[8];
#pragma unroll
                    for (int n = 0; n < 2; ++n)
#pragma unroll
                        for (int q = 0; q < 4; ++q) { const float a = acc[ai][0][m][n][q] * sc, g = acc[ai][1][m][n][q] * sc;
                            o[4 * n + q] = kind == 1 ? a * __builtin_amdgcn_rcpf(1.f + __builtin_amdgcn_exp2f(-1.44269504089f * g)) : a * g; }
                    u32x4 w; w.x = cvt_pk_bf16(o[0], o[1]); w.y = cvt_pk_bf16(o[2], o[3]); w.z = cvt_pk_bf16(o[4], o[5]); w.w = cvt_pk_bf16(o[6], o[7]);
                    *(u32x4*)rowp = w;
                }
            }
    }
};
typedef EpiPT<(G1_FP8 != 0), 0> EpiP;
struct EpiX {
    static constexpr bool PERM = true; bf16* X; const void* R0; const void* R1; const float* g1; float* SS; int rf32;
    struct Pre { f32x4 gv[2][2]; };
    __device__ __forceinline__ void prefetch(Pre& p, const GU& u, int wr, int wc, int fr, int fq) const {
        const float* g = g1 + (size_t)tok_modrow(u.pm * BM) * MODW + u.pn * BM + wc * 32 + 8 * fq;
#pragma unroll
        for (int bj = 0; bj < 2; ++bj)
#pragma unroll
            for (int n = 0; n < 2; ++n) p.gv[bj][n] = *(const f32x4*)(g + bj * HALF + 4 * n);
    }
    __device__ __forceinline__ void operator()(const f32x4 (&acc)[2][2][4][2], const GU& u, int wr, int wc, int fr, int fq, const Pre& pre) const {
        const int row0 = u.pm * BM + wr * 64 + fr, col0 = u.pn * BM + wc * 32 + 8 * fq;
        const bool lat = u.pm * BM < NLAT; const size_t roff = (size_t)(lat ? row0 : row0 - NLAT) * D + col0;
        const f32x4 (&gv)[2][2] = pre.gv;
#pragma unroll
        for (int ai = 0; ai < 2; ++ai) {
            f32x4 rv[4][2][2];
            if (rf32) { const float* R = (const float*)(lat ? R0 : R1) + roff;
#pragma unroll
                for (int m = 0; m < 4; ++m)
#pragma unroll
                    for (int bj = 0; bj < 2; ++bj)
#pragma unroll
                        for (int n = 0; n < 2; ++n) rv[m][bj][n] = *(const f32x4*)(R + (size_t)(ai * HALF + m * 16) * D + bj * HALF + 4 * n);
            } else { const bf16* R = (const bf16*)(lat ? R0 : R1) + roff; u32x4 rw[4][2];
#pragma unroll
                for (int m = 0; m < 4; ++m)
#pragma unroll
                    for (int bj = 0; bj < 2; ++bj) rw[m][bj] = *(const u32x4*)(R + (size_t)(ai * HALF + m * 16) * D + bj * HALF);
#pragma unroll
                for (int m = 0; m < 4; ++m)
#pragma unroll
                    for (int bj = 0; bj < 2; ++bj) { const u32x4 w = rw[m][bj]; rv[m][bj][0] = (f32x4){blo(w.x), bhi(w.x), blo(w.y), bhi(w.y)}; rv[m][bj][1] = (f32x4){blo(w.z), bhi(w.z), blo(w.w), bhi(w.w)}; }
            }
#pragma unroll
            for (int m = 0; m < 4; ++m) { bf16* rowp = X + (size_t)(row0 + ai * HALF + m * 16) * D + col0; float ssq = 0.f;
#pragma unroll
                for (int bj = 0; bj < 2; ++bj) { const f32x4 v0 = rv[m][bj][0] + gv[bj][0] * acc[ai][bj][m][0], v1 = rv[m][bj][1] + gv[bj][1] * acc[ai][bj][m][1];
                    ssq += (v0[0] * v0[0] + v0[1] * v0[1]) + (v0[2] * v0[2] + v0[3] * v0[3]) + (v1[0] * v1[0] + v1[1] * v1[1]) + (v1[2] * v1[2] + v1[3] * v1[3]);
                    u32x4 w; w.x = cvt_pk_bf16(v0[0], v0[1]); w.y = cvt_pk_bf16(v0[2], v0[3]); w.z = cvt_pk_bf16(v1[0], v1[1]); w.w = cvt_pk_bf16(v1[2], v1[3]);
                    *(u32x4*)(rowp + bj * HALF) = w; }
                ssq += __shfl_xor(ssq, 16); ssq += __shfl_xor(ssq, 32);
                if (fq == 0) SS[(size_t)(row0 + ai * HALF + m * 16) * 16 + 4 * u.pn + wc] = ssq; }
        }
    }
};
constexpr float W8_SCALE = 64.f, HID_SCALE = 4.f, O8_SCALE = 8.f;
struct EpiHid {
    static constexpr bool PERM = true; bf16* HID; const float* bgu; const LAS int* tb;
    struct Pre { f32x4 bgl[2], bup[2]; };
    __device__ __forceinline__ void prefetch(Pre& p, const GU& u, int wr, int wc, int fr, int fq) const {
        const float* bg = bgu + (size_t)u.e * 2 * FF + u.pn * HALF + wc * 32 + 8 * fq;
#pragma unroll
        for (int n = 0; n < 2; ++n) { p.bgl[n] = *(const f32x4*)(bg + 4 * n); p.bup[n] = *(const f32x4*)(bg + FF + 4 * n); }
    }
    __device__ __forceinline__ void operator()(const f32x4 (&acc)[2][2][4][2], const GU& u, int wr, int wc, int fr, int fq, const Pre& pre) const {
        const int row0 = (__builtin_amdgcn_readfirstlane(tb[u.e]) + u.pm) * BM + wr * 64 + fr, j0 = u.pn * HALF + wc * 32 + 8 * fq;
        const f32x4 (&bgl)[2] = pre.bgl; const f32x4 (&bup)[2] = pre.bup;
        const int odd = fq & 1;
#pragma unroll
        for (int ai = 0; ai < 2; ++ai)
#pragma unroll
            for (int mp = 0; mp < 2; ++mp) {
                u32x2 w[2];
#pragma unroll
                for (int t = 0; t < 2; ++t) { const int m = 2 * mp + t; float hv[8];
#pragma unroll
                    for (int n = 0; n < 2; ++n)
#pragma unroll
                        for (int q = 0; q < 4; q += 2) {
                            typedef float f2 __attribute__((ext_vector_type(2)));
                            f2 gl = (f2){acc[ai][0][m][n][q], acc[ai][0][m][n][q + 1]} * (1.f / W8_SCALE) + (f2){bgl[n][q], bgl[n][q + 1]};
                            f2 up = (f2){acc[ai][1][m][n][q], acc[ai][1][m][n][q + 1]} * (1.f / W8_SCALE) + (f2){bup[n][q], bup[n][q + 1]};
                            gl.x = fminf(gl.x, 7.f); gl.y = fminf(gl.y, 7.f); up.x = fminf(fmaxf(up.x, -7.f), 7.f); up.y = fminf(fmaxf(up.y, -7.f), 7.f);
                            const f2 ar = gl * (-1.702f * 1.44269504089f); f2 dn; dn.x = __builtin_amdgcn_exp2f(ar.x); dn.y = __builtin_amdgcn_exp2f(ar.y); dn = dn + 1.f;
                            f2 rc; rc.x = __builtin_amdgcn_rcpf(dn.x); rc.y = __builtin_amdgcn_rcpf(dn.y);
                            const f2 hh = (up * HID_SCALE + HID_SCALE) * gl * rc; hv[4 * n + q] = hh.x; hv[4 * n + q + 1] = hh.y; }
                    w[t].x = (unsigned)__builtin_amdgcn_cvt_pk_fp8_f32(hv[0], hv[1], 0, false); w[t].x = (unsigned)__builtin_amdgcn_cvt_pk_fp8_f32(hv[2], hv[3], (int)w[t].x, true);
                    w[t].y = (unsigned)__builtin_amdgcn_cvt_pk_fp8_f32(hv[4], hv[5], 0, false); w[t].y = (unsigned)__builtin_amdgcn_cvt_pk_fp8_f32(hv[6], hv[7], (int)w[t].y, true); }
                const u32x2 send = odd ? w[0] : w[1], keep = odd ? w[1] : w[0];
                u32x2 recv; recv.x = (unsigned)__shfl_xor((int)send.x, 16); recv.y = (unsigned)__shfl_xor((int)send.y, 16);
                const u32x4 o = odd ? (u32x4){recv.x, recv.y, keep.x, keep.y} : (u32x4){keep.x, keep.y, recv.x, recv.y};
                *(u32x4*)((unsigned char*)HID + (size_t)(row0 + ai * HALF + (2 * mp + odd) * 16) * FF + (j0 - 8 * odd)) = o; }
    }
};
struct EpiO {
    static constexpr bool PERM = true; unsigned char* O8; const float* bdn;
    struct Pre { f32x4 bv[2][2]; };
    __device__ __forceinline__ void prefetch(Pre& p, const GU& u, int wr, int wc, int fr, int fq) const {
        const float* bp = bdn + (size_t)u.e * D + u.pn * BM + wc * 32 + 8 * fq;
#pragma unroll
        for (int bj = 0; bj < 2; ++bj)
#pragma unroll
            for (int n = 0; n < 2; ++n) p.bv[bj][n] = *(const f32x4*)(bp + bj * HALF + 4 * n);
    }
    __device__ __forceinline__ void operator()(const f32x4 (&acc)[2][2][4][2], const GU& u, int wr, int wc, int fr, int fq, const Pre& pre) const {
        const int r0 = wr * 64 + fr, col0 = u.pn * BM + wc * 32 + 8 * fq, odd = fq & 1;
        f32x4 bv[2][2];
#pragma unroll
        for (int bj = 0; bj < 2; ++bj)
#pragma unroll
            for (int n = 0; n < 2; ++n) bv[bj][n] = pre.bv[bj][n] * O8_SCALE;
        constexpr float sc = O8_SCALE / (W8_SCALE * HID_SCALE);
#pragma unroll
        for (int ai = 0; ai < 2; ++ai)
#pragma unroll
            for (int mp = 0; mp < 2; ++mp) {
                const int r = r0 + ai * HALF + (2 * mp + odd) * 16;
                const bool ok = r < u.nvalid; const int slot = ok ? u.tab[r] : 0;
                unsigned char* rowp = O8 + (size_t)slot * D + (col0 - 8 * odd);
#pragma unroll
                for (int bj = 0; bj < 2; ++bj) {
                    u32x2 w[2];
#pragma unroll
                    for (int q = 0; q < 2; ++q) { const f32x4 v0 = acc[ai][bj][2 * mp + q][0] * sc + bv[bj][0], v1 = acc[ai][bj][2 * mp + q][1] * sc + bv[bj][1];
                        w[q].x = (unsigned)__builtin_amdgcn_cvt_pk_fp8_f32(v0[0], v0[1], 0, false); w[q].x = (unsigned)__builtin_amdgcn_cvt_pk_fp8_f32(v0[2], v0[3], (int)w[q].x, true);
                        w[q].y = (unsigned)__builtin_amdgcn_cvt_pk_fp8_f32(v1[0], v1[1], 0, false); w[q].y = (unsigned)__builtin_amdgcn_cvt_pk_fp8_f32(v1[2], v1[3], (int)w[q].y, true); }
                    const u32x2 send = odd ? w[0] : w[1], keep = odd ? w[1] : w[0];
                    u32x2 recv; recv.x = (unsigned)__shfl_xor((int)send.x, 16); recv.y = (unsigned)__shfl_xor((int)send.y, 16);
                    const u32x4 o = odd ? (u32x4){recv.x, recv.y, keep.x, keep.y} : (u32x4){keep.x, keep.y, recv.x, recv.y};
                    if (ok) *(u32x4*)(rowp + bj * HALF) = o;
                }
            }
    }
};
}


#define XB_TMO      128
#define XB_XCNT(j)  (256  + 64 * (j))
#define XB_XSUB(j)  (1280 + 64 * (j))
#define XB_XGEN(j)  (2304 + 64 * (j))
#define XB_TOP      3328
#define XB_TOPGEN   3392
#define XCD_BAR_WORDS 3456
#define XB_SPIN_CAP (1u << 18)

__device__ __forceinline__ unsigned xb_ld(unsigned* p)              { return __hip_atomic_load(p, __ATOMIC_RELAXED, __HIP_MEMORY_SCOPE_AGENT); }
__device__ __forceinline__ unsigned xb_add(unsigned* p, unsigned v) { return __hip_atomic_fetch_add(p, v, __ATOMIC_RELAXED, __HIP_MEMORY_SCOPE_AGENT); }
__device__ __forceinline__ unsigned xb_xcc_id() { return (unsigned)__builtin_amdgcn_s_getreg((3 << 11) | 20) & 0xFu; }
#define XB_SPIN(cond, bar) do { unsigned _sp = 0; while (cond) { __builtin_amdgcn_s_sleep(1); \
    if ((++_sp & 255u) == 0u) { if (xb_ld(&(bar)[XB_TMO])) break; if (_sp > XB_SPIN_CAP) { atomicAdd(&(bar)[XB_TMO], 1u); break; } } } } while (0)

struct XcdBarrier {
    unsigned* bar; unsigned x; unsigned gsize; unsigned w;
    volatile LAS unsigned* st;
};

__device__ __forceinline__ XcdBarrier xcd_barrier_post(unsigned* bar, volatile LAS unsigned* st, unsigned gsize, unsigned w) {
    XcdBarrier b; b.bar = bar; b.x = xb_xcc_id(); b.st = st; b.gsize = gsize; b.w = w;
    if (b.w == 0u && mk_lane() == 0) (void)xb_add(&bar[XB_XCNT(b.x)], 1u);
    return b;
}
__device__ __forceinline__ void xcd_barrier_complete(unsigned* bar, unsigned x, unsigned& nloc, unsigned& nx, unsigned G) {
    unsigned sum, cnt, mine, sp = 0u;
    for (;;) {
        sum = 0u; cnt = 0u; mine = 0u;
#pragma unroll
        for (unsigned j = 0; j < 16; ++j) { const unsigned c = xb_ld(&bar[XB_XCNT(j)]); sum += c; cnt += (c > 0u) ? 1u : 0u; mine = (j == x) ? c : mine; }
        if (sum == G) break;
        __builtin_amdgcn_s_sleep(1);
        if ((++sp & 255u) == 0u) { if (xb_ld(&bar[XB_TMO])) break; if (sp > XB_SPIN_CAP) { atomicAdd(&bar[XB_TMO], 1u); break; } }
    }
    nloc = mine > 0u ? mine : 1u; nx = cnt > 0u ? cnt : 1u;
}

__device__ __forceinline__ void xcd_barrier(const XcdBarrier& b) {
    asm volatile("s_waitcnt vmcnt(0)" ::: "memory");
    __syncthreads();
    if (b.w == 0u && mk_lane() == 0) {
        unsigned* bar = b.bar;
        __builtin_amdgcn_s_waitcnt(0);
        unsigned nloc = b.st[0], nx = b.st[1];
        if (nloc == 0u) { xcd_barrier_complete(bar, b.x, nloc, nx, b.gsize); b.st[0] = nloc; b.st[1] = nx; }
        const unsigned old = xb_add(&bar[XB_XSUB(b.x)], 1u);
        const unsigned gen = old / nloc;
        if (old + 1u == (gen + 1u) * nloc) {
            __builtin_amdgcn_fence(__ATOMIC_RELEASE, "agent");
            asm volatile("s_waitcnt vmcnt(0)" ::: "memory");
            const unsigned og = xb_add(&bar[XB_TOP], 1u);
            const unsigned tg = og / nx;
            if (og + 1u == (tg + 1u) * nx) xb_add(&bar[XB_TOPGEN], 1u);
            else XB_SPIN(xb_ld(&bar[XB_TOPGEN]) == tg, bar);
            __builtin_amdgcn_fence(__ATOMIC_ACQUIRE, "agent");
            xb_add(&bar[XB_XGEN(b.x)], 1u);
            asm volatile("s_waitcnt vmcnt(0)" ::: "memory");
        } else {
            XB_SPIN(xb_ld(&bar[XB_XGEN(b.x)]) == gen, bar);
            __builtin_amdgcn_fence(__ATOMIC_ACQUIRE, "agent");
            asm volatile("s_waitcnt vmcnt(0)" ::: "memory");
        }
    }
    __syncthreads();
}

constexpr int LDS_STAGE = 131072, LDS_MISC = 135168, LDS_BYTES = 147456;
struct Args { const float* in[31]; float* out; unsigned char* ws; int ph_lo, ph_hi; };

template <int MAP> __device__ __forceinline__ int map_col(int n) {
    if (MAP == 0) return n;
    const int up = n >= FF ? 1 : 0, j = n - up * FF; return (j >> 7) * 256 + up * 128 + (j & 127);
}
__device__ __forceinline__ int map_win(int n) { const int g = n >> 8, c = n & 255;
    if (g == 5 || g == 6) return (5 + (c >> 7)) * 256 + (g - 5) * 128 + (c & 127);
    if (g == 8 || g == 9) return (8 + (c >> 7)) * 256 + (g - 8) * 128 + (c & 127);
    return n; }
struct TItem { const float* W; bf16* WT; int K, N, k0, n0, r0, f8; };
__device__ __forceinline__ bool t_decode(long it, int part, const float* w_in, const float* w_out, const float* w_gu, const float* w_dn, bf16* WIN, bf16* WOUT, bf16* WGU, bf16* WDN, unsigned char* WINQ, TItem& t) {
    constexpr int NB_IN = (G1_QLO == 0) ? (DIN - G1_QHI * 256) / 32 : DIN / 32;
    constexpr int I_IN = (D / 128) * NB_IN, I_OUT = (D / 128) * (D / 32), I_GU = (D / 128) * (2 * FF / 32), I_DN = (FF / 128) * (D / 32);
    constexpr long T_IN = (long)NL * I_IN, T_OUT = (long)NL * I_OUT, T_GU = (long)NL * NE * I_GU, T_DN = (long)NL * NE * I_DN;
    if (part == 0) return false;
    if (part == 3) { if (it >= T_IN + T_OUT) {
            constexpr int I_INQ = (D / 128) * (DINQ / 32); it -= T_IN + T_OUT; if (DINQ == 0 || it >= (long)NL * I_INQ) return false;
            const int m = (int)(it / I_INQ), i = (int)(it % I_INQ), nblk = DINQ / 32, kb = i / nblk, nb = i % nblk;
            t.W = w_in + (size_t)m * D * DIN; t.WT = (bf16*)(WINQ + (size_t)m * DINQ * D); t.K = D; t.N = DIN; t.f8 = 1; t.k0 = 128 * kb; t.n0 = G1_QLO * 256 + 32 * nb; t.r0 = map_win(t.n0) - G1_QLO * 256;
            return true; } }
    else { const int l = part - 1; if (it >= (long)NE * (I_GU + I_DN)) return false; it = it < (long)NE * I_GU ? T_IN + T_OUT + (long)l * NE * I_GU + it : T_IN + T_OUT + T_GU + (long)l * NE * I_DN + (it - (long)NE * I_GU); }
    if (it >= T_IN + T_OUT + T_GU + T_DN) return false;
    int m, i, map = 0;
    if (it < T_IN) { m = (int)(it / I_IN); i = (int)(it % I_IN); t.W = w_in + (size_t)m * D * DIN; t.WT = G1_FP8 ? (bf16*)((unsigned char*)WIN + (size_t)m * DIN * D) : WIN + (size_t)m * DIN * D; t.K = D; t.N = DIN; t.f8 = G1_FP8; map = 2; }
    else if (it < T_IN + T_OUT) { it -= T_IN; m = (int)(it / I_OUT); i = (int)(it % I_OUT); t.W = w_out + (size_t)m * D * D; t.WT = WOUT + (size_t)m * D * D; t.K = D; t.N = D; t.f8 = 0; }
    else if (it < T_IN + T_OUT + T_GU) { it -= T_IN + T_OUT; m = (int)(it / I_GU); i = (int)(it % I_GU); t.W = w_gu + (size_t)m * D * 2 * FF; t.WT = (bf16*)((unsigned char*)WGU + (size_t)m * 2 * FF * D); t.K = D; t.N = 2 * FF; map = 1; t.f8 = 1; }
    else { it -= T_IN + T_OUT + T_GU; m = (int)(it / I_DN); i = (int)(it % I_DN); t.W = w_dn + (size_t)m * FF * D; t.WT = (bf16*)((unsigned char*)WDN + (size_t)m * D * FF); t.K = FF; t.N = D; t.f8 = 1; }
    const int nblk = map == 2 ? NB_IN : t.N / 32, kb = i / nblk, nb = i % nblk; t.k0 = 128 * kb; t.n0 = (map == 2 ? DIN - NB_IN * 32 : 0) + 32 * nb; t.r0 = map == 1 ? map_col<1>(t.n0) : (map == 2 ? map_win(t.n0) : t.n0);
    return true;
}
__device__ __forceinline__ void t_load(const TItem& t, int lane, f32x4 (&v)[16]) {
#pragma unroll
    for (int i = 0; i < 16; ++i) { const int kk = 8 * i + (lane >> 3); v[i] = __builtin_nontemporal_load((const f32x4*)(t.W + (size_t)(t.k0 + kk) * t.N + t.n0 + 4 * (lane & 7))); }
}
__device__ __forceinline__ void t_store(const TItem& t, int lane, const f32x4 (&v)[16], LAS float* scr) {
#pragma unroll
    for (int i = 0; i < 16; ++i) { const int kk = 8 * i + (lane >> 3); LAS float* p = scr + kk * 33 + 4 * (lane & 7); p[0] = v[i].x; p[1] = v[i].y; p[2] = v[i].z; p[3] = v[i].w; }
    LDS_WAIT();
    const int n = lane >> 1, hh = lane & 1; const LAS float* s = scr + (64 * hh) * 33 + n;
    if (t.f8) {
        unsigned w[16];
#pragma unroll
        for (int q = 0; q < 16; ++q) { int x = __builtin_amdgcn_cvt_pk_fp8_f32(s[(4 * q) * 33] * pg8::W8_SCALE, s[(4 * q + 1) * 33] * pg8::W8_SCALE, 0, false);
            x = __builtin_amdgcn_cvt_pk_fp8_f32(s[(4 * q + 2) * 33] * pg8::W8_SCALE, s[(4 * q + 3) * 33] * pg8::W8_SCALE, x, true); w[q] = (unsigned)x; }
        unsigned char* dst = (unsigned char*)t.WT + (size_t)(t.r0 + n) * t.K + t.k0 + 64 * hh;
#pragma unroll
        for (int q = 0; q < 4; ++q) *(u32x4*)(dst + 16 * q) = (u32x4){w[4 * q], w[4 * q + 1], w[4 * q + 2], w[4 * q + 3]};
    } else {
        bf16* dst = t.WT + (size_t)(t.r0 + n) * t.K + t.k0 + 64 * hh;
#pragma unroll
        for (int q = 0; q < 8; ++q) { u32x4 o; o.x = pk2(s[(8 * q) * 33], s[(8 * q + 1) * 33]); o.y = pk2(s[(8 * q + 2) * 33], s[(8 * q + 3) * 33]); o.z = pk2(s[(8 * q + 4) * 33], s[(8 * q + 5) * 33]); o.w = pk2(s[(8 * q + 6) * 33], s[(8 * q + 7) * 33]);
            *(u32x4*)(dst + 8 * q) = o; }
    }
    LDS_WAIT();
}
__device__ __forceinline__ void ph_prologue(LAS unsigned char* lds, const Args& a, const Grp grp, int part, long it_lo = 0, long it_hi = (1L << 40)) {
    int tid_ = MK_TID(grp); asm volatile("" : "+v"(tid_)); const int tid = tid_, wave = tid >> 6, lane = tid & 63, G = grp.n, vcu = grp.v;
    const float* c = a.in[1]; const float* c_ctx = a.in[3]; const float* w_mod = a.in[4]; const float* b_mod = a.in[5];
    float* mod = (float*)(a.ws + WS_MOD);
    if (part == 0) { LAS float* sc = (LAS float*)lds; LAS float* part_ = sc + 17 * D;
      for (int it = vcu; it < NL * (MODW / 64); it += G) {
        const int l = it / (MODW / 64), cb = it % (MODW / 64), col = tid & 63, w = tid >> 6;
        __syncthreads();
        for (int idx = tid; idx < 17 * D; idx += 512) { const int r = idx >> 10, k = idx & 1023; sc[idx] = silu_f(r < 16 ? c[r * D + k] : c_ctx[k]); }
        __syncthreads();
        float acc[17];
#pragma unroll
        for (int r = 0; r < 17; ++r) acc[r] = 0.f;
        const float* wp = w_mod + ((size_t)l * D + 128 * w) * MODW + cb * 64 + col;
#pragma unroll 4
        for (int kk = 0; kk < 128; kk += 4) {
            const float w0 = wp[(size_t)kk * MODW], w1 = wp[(size_t)(kk + 1) * MODW], w2 = wp[(size_t)(kk + 2) * MODW], w3 = wp[(size_t)(kk + 3) * MODW];
#pragma unroll
            for (int r = 0; r < 17; ++r) { const f32x4 s = *(const LAS f32x4*)(sc + r * D + 128 * w + kk); acc[r] += s.x * w0 + s.y * w1 + s.z * w2 + s.w * w3; }
        }
#pragma unroll
        for (int r = 0; r < 17; ++r) part_[(w * 17 + r) * 64 + col] = acc[r];
        __syncthreads();
        for (int idx = tid; idx < 17 * 64; idx += 512) { const int r = idx >> 6, cc = idx & 63; float s = 0.f;
#pragma unroll
            for (int ww = 0; ww < 8; ++ww) s += part_[(ww * 17 + r) * 64 + cc];
            mod[((size_t)l * 17 + r) * MODW + cb * 64 + cc] = s + b_mod[l * MODW + cb * 64 + cc]; }
      }
      __syncthreads(); }
    if (part == 0) { unsigned char* rwt = a.ws + WS_RWT;
      for (int idx = vcu * 512 + tid; idx < NL * D * NE; idx += G * 512) { const int l = idx / (D * NE), r = idx % (D * NE), k = r >> 5, e = r & 31; const float w = a.in[25][idx];
          const bf16 hi = f2bf(w), lo = f2bf(w - bf2f(hi)); bf16* dst = (bf16*)(rwt + (size_t)l * (2 * 32 * 2064) + (size_t)e * 2064) + k; dst[0] = hi; *(bf16*)((unsigned char*)dst + 32 * 2064) = lo; } }
    __syncthreads();
    LAS float* scr = (LAS float*)(lds + wave * 16896);
    bf16* WIN = (bf16*)(a.ws + WS_WIN); bf16* WOUT = (bf16*)(a.ws + WS_WOUT); bf16* WGU = (bf16*)(a.ws + WS_WGU); bf16* WDN = (bf16*)(a.ws + WS_WDN);
    const long gw = (long)vcu * 8 + wave, ngw = (long)G * 8;
    TItem cur, nxt; f32x4 vc[16], vn[16];
    long it = it_lo + gw; bool have = it < it_hi && t_decode(it, part, a.in[8], a.in[24], a.in[27], a.in[29], WIN, WOUT, WGU, WDN, a.ws + WS_WINQ, cur);
    if (have) t_load(cur, lane, vc);
    while (have) {
        it += ngw; const bool hn = it < it_hi && t_decode(it, part, a.in[8], a.in[24], a.in[27], a.in[29], WIN, WOUT, WGU, WDN, a.ws + WS_WINQ, nxt);
        if (hn) t_load(nxt, lane, vn);
        t_store(cur, lane, vc, scr);
        cur = nxt; have = hn;
#pragma unroll
        for (int i = 0; i < 16; ++i) vc[i] = vn[i];
    }
}

struct RowIn { u32x4 ow[4]; u32x4 xw[2]; f32x4 gt; };
struct Coef { f32x4 a[4], b[4], g2[4]; };
__device__ __forceinline__ void row_load(RowIn& r, bool from_input, const float* src_f32, const bf16* X, const unsigned char* O8, const float* gate, int tok, int lane) {
    if (from_input) {
#pragma unroll
        for (int q = 0; q < 4; ++q) r.ow[q] = *(const u32x4*)(src_f32 + 16 * lane + 4 * q);
    } else {
        r.xw[0] = *(const u32x4*)(X + (size_t)tok * D + 16 * lane); r.xw[1] = *(const u32x4*)(X + (size_t)tok * D + 16 * lane + 8);
#pragma unroll
        for (int k = 0; k < 4; ++k) r.ow[k] = *(const u32x4*)(O8 + (size_t)(tok * 4 + k) * D + 16 * lane);
        r.gt = *(const f32x4*)(gate + (size_t)tok * 4);
    }
}
__device__ __forceinline__ void coef_load(Coef& c, int l, int mr, int lane, const float* mod, const float* norm_g, bool with_norm) {
    if (with_norm) { const float* mrow = mod + ((size_t)l * 17 + mr) * MODW + 16 * lane;
#pragma unroll
        for (int q = 0; q < 4; ++q) { const f32x4 g = *(const f32x4*)(norm_g + 16 * lane + 4 * q), sh = *(const f32x4*)(mrow + 4 * q), sc = *(const f32x4*)(mrow + D + 4 * q); c.a[q] = g * (1.f + sc); c.b[q] = sh; } }
    if (l > 0) {
#pragma unroll
        for (int q = 0; q < 4; ++q) c.g2[q] = *(const f32x4*)(mod + ((size_t)(l - 1) * 17 + mr) * MODW + 5 * D + 16 * lane + 4 * q); }
}
__device__ __forceinline__ void combine16(const RowIn& r, const Coef& c, float (&v)[16]) {
    float s[16];
#pragma unroll
    for (int i = 0; i < 16; ++i) s[i] = 0.f;
#pragma unroll
    for (int k = 0; k < 4; ++k) { const float gk = r.gt[k] * (1.f / pg8::O8_SCALE);
#pragma unroll
        for (int q = 0; q < 4; ++q) { const f32x2 lo = __builtin_amdgcn_cvt_pk_f32_fp8((int)r.ow[k][q], false), hi = __builtin_amdgcn_cvt_pk_f32_fp8((int)r.ow[k][q], true);
            s[4 * q] += gk * lo.x; s[4 * q + 1] += gk * lo.y; s[4 * q + 2] += gk * hi.x; s[4 * q + 3] += gk * hi.y; } }
#pragma unroll
    for (int q = 0; q < 4; ++q) { const f32x4 g2 = c.g2[q]; const unsigned w0 = r.xw[q >> 1][(q & 1) * 2], w1 = r.xw[q >> 1][(q & 1) * 2 + 1];
        v[4 * q] = blo(w0) + g2.x * s[4 * q]; v[4 * q + 1] = bhi(w0) + g2.y * s[4 * q + 1]; v[4 * q + 2] = blo(w1) + g2.z * s[4 * q + 2]; v[4 * q + 3] = bhi(w1) + g2.w * s[4 * q + 3]; }
}
__device__ __forceinline__ void norm1_row(const RowIn& r, const Coef& c, int l, int tok, int lane, bf16* Xd, bf16* H, unsigned char* HQ) {
    float v[16];
    if (l == 0) {
#pragma unroll
        for (int q = 0; q < 4; ++q) { v[4 * q] = __uint_as_float(r.ow[q].x); v[4 * q + 1] = __uint_as_float(r.ow[q].y); v[4 * q + 2] = __uint_as_float(r.ow[q].z); v[4 * q + 3] = __uint_as_float(r.ow[q].w); }
    } else {
        combine16(r, c, v);
        u32x4 o0, o1; o0.x = pk2(v[0], v[1]); o0.y = pk2(v[2], v[3]); o0.z = pk2(v[4], v[5]); o0.w = pk2(v[6], v[7]); o1.x = pk2(v[8], v[9]); o1.y = pk2(v[10], v[11]); o1.z = pk2(v[12], v[13]); o1.w = pk2(v[14], v[15]);
        *(u32x4*)(Xd + (size_t)tok * D + 16 * lane) = o0; *(u32x4*)(Xd + (size_t)tok * D + 16 * lane + 8) = o1;
    }
    float ss = 0.f;
#pragma unroll
    for (int i = 0; i < 16; ++i) ss += v[i] * v[i];
    const float rstd = rsqrtf(wave_sum(ss) * (1.f / D) + EPS);
    unsigned hw[8];
#pragma unroll
    for (int q = 0; q < 4; ++q) { const f32x4 ca = c.a[q], cb = c.b[q];
        hw[2 * q] = pk2(v[4 * q] * rstd * ca.x + cb.x, v[4 * q + 1] * rstd * ca.y + cb.y); hw[2 * q + 1] = pk2(v[4 * q + 2] * rstd * ca.z + cb.z, v[4 * q + 3] * rstd * ca.w + cb.w); }
    *(u32x4*)(H + (size_t)tok * D + 16 * lane) = (u32x4){hw[0], hw[1], hw[2], hw[3]}; *(u32x4*)(H + (size_t)tok * D + 16 * lane + 8) = (u32x4){hw[4], hw[5], hw[6], hw[7]};
    if (DINQ > 0) { u32x4 w8;
#pragma unroll
        for (int q = 0; q < 4; ++q) { int t8 = __builtin_amdgcn_cvt_pk_fp8_f32(blo(hw[2 * q]), bhi(hw[2 * q]), 0, false); t8 = __builtin_amdgcn_cvt_pk_fp8_f32(blo(hw[2 * q + 1]), bhi(hw[2 * q + 1]), t8, true); w8[q] = (unsigned)t8; }
        *(u32x4*)(HQ + (size_t)tok * D + 16 * lane) = w8; }
}
__device__ __forceinline__ void ph_norm1(int l, const Args& a, const Grp grp) {
    int tid_ = MK_TID(grp); asm volatile("" : "+v"(tid_)); const int tid = tid_, lane = tid & 63, gw = grp.v * 8 + __builtin_amdgcn_readfirstlane(tid >> 6), ngw = grp.n * 8;
    const float* xin = a.in[0]; const float* ctxin = a.in[2]; const float* norm_g = a.in[6] + l * D;
    const bf16* X = (const bf16*)(a.ws + WS_X); bf16* Xd = (bf16*)(a.ws + WS_X); const unsigned char* O8 = a.ws + WS_O; const float* gate = (const float*)(a.ws + WS_GATE); const float* mod = (const float*)(a.ws + WS_MOD); bf16* H = (bf16*)(a.ws + WS_H); unsigned char* HQ = a.ws + WS_HQ;
    const int rpw = (GTOK + ngw - 1) / ngw, t0 = gw * rpw, t1 = (t0 + rpw < GTOK) ? t0 + rpw : GTOK;
    if (t0 >= t1) return;
    Coef c; int cmr = -1;
    RowIn ra, rb, rc;
#define N1_LOAD(r, t) do { const int _tk = gtok(grp.g, (t) < t1 ? (t) : t1 - 1); row_load(r, l == 0, _tk < NLAT ? xin + (size_t)_tk * D : ctxin + (size_t)(_tk - NLAT) * D, X, O8, gate, _tk, lane); } while (0)
#define N1_ROW(r, t) do { if ((t) < t1) { const int _tk = gtok(grp.g, (t)), _mr = tok_modrow(_tk); if (_mr != cmr) { cmr = _mr; coef_load(c, l, _mr, lane, mod, norm_g, true); } norm1_row(r, c, l, _tk, lane, Xd, H, HQ); } } while (0)
    N1_LOAD(ra, t0); N1_LOAD(rb, t0 + 1);
    for (int t = t0; t < t1; t += 3) {
        N1_LOAD(rc, t + 2); N1_ROW(ra, t);
        N1_LOAD(ra, t + 3); N1_ROW(rb, t + 1);
        N1_LOAD(rb, t + 4); N1_ROW(rc, t + 2);
    }
#undef N1_LOAD
#undef N1_ROW
}
__device__ __forceinline__ void ph_final(const Args& a, const Grp grp) {
    int tid_ = MK_TID(grp); asm volatile("" : "+v"(tid_)); const int tid = tid_, lane = tid & 63, gw = grp.v * 8 + __builtin_amdgcn_readfirstlane(tid >> 6), ngw = grp.n * 8;
    const bf16* X = (const bf16*)(a.ws + WS_X); const unsigned char* O8 = a.ws + WS_O; const float* gate = (const float*)(a.ws + WS_GATE); const float* mod = (const float*)(a.ws + WS_MOD);
    const int rpw = (GLAT + ngw - 1) / ngw, t0 = gw * rpw, t1 = (t0 + rpw < GLAT) ? t0 + rpw : GLAT;
    if (t0 >= t1) return;
    Coef c; int cmr = -1;
    RowIn ra, rb, rc;
#define FN_LOAD(r, t) row_load(r, false, nullptr, X, O8, gate, grp.g * GLAT + ((t) < t1 ? (t) : t1 - 1), lane)
#define FN_ROW(r, t) do { if ((t) < t1) { const int _tk = grp.g * GLAT + (t), _mr = tok_modrow(_tk); if (_mr != cmr) { cmr = _mr; coef_load(c, NL, _mr, lane, mod, nullptr, false); } float v[16]; combine16(r, c, v); \
        _Pragma("unroll") for (int q = 0; q < 4; ++q) *(f32x4*)(a.out + (size_t)_tk * D + 16 * lane + 4 * q) = (f32x4){v[4 * q], v[4 * q + 1], v[4 * q + 2], v[4 * q + 3]}; } } while (0)
    FN_LOAD(ra, t0); FN_LOAD(rb, t0 + 1);
    for (int t = t0; t < t1; t += 3) {
        FN_LOAD(rc, t + 2); FN_ROW(ra, t);
        FN_LOAD(ra, t + 3); FN_ROW(rb, t + 1);
        FN_LOAD(rb, t + 4); FN_ROW(rc, t + 2);
    }
#undef FN_LOAD
#undef FN_ROW
}

__device__ __forceinline__ void ph_prep(int l, const Args& a, const Grp grp) {
    int tid_ = MK_TID(grp); asm volatile("" : "+v"(tid_)); const int tid = tid_, lane = tid & 63, G = grp.n, vcu = grp.v;
    bf16* P = (bf16*)(a.ws + WS_P); bf16* VT = (bf16*)(a.ws + WS_VT);
    const float* qg = a.in[12]; const float* kg = a.in[13];
    const int gw = vcu * 8 + (tid >> 6), ngw = G * 8;
    for (int it = gw; it < (GTOK / 64) * 4; it += ngw) {
        const int h = it & 3, tok0 = gtok(grp.g, (it >> 2) * 64), tok = tok0 + lane;
        int b, key0; if (tok < NLAT) { b = tok >> 11; key0 = tok0 & 2047; } else { b = (tok - NLAT) >> 8; key0 = 2048 + ((tok0 - NLAT) & 255); }
        const int g = lane >> 5, k32 = lane & 31, pos = g * 32 + ((k32 & 15) >> 2) * 8 + (k32 >> 4) * 4 + (k32 & 3);
        const bf16* vp = P + (size_t)tok * DINP + 1024 + h * 64;
        bf16* dst = VT + ((size_t)(b * 4 + h) * 64) * NKEY + key0 + pos;
#pragma unroll
        for (int q = 0; q < 8; ++q) { const u32x4 w = *(const u32x4*)(vp + 8 * q);
            dst[(size_t)(8 * q + 0) * NKEY] = (bf16)(w.x & 0xffffu); dst[(size_t)(8 * q + 1) * NKEY] = (bf16)(w.x >> 16); dst[(size_t)(8 * q + 2) * NKEY] = (bf16)(w.y & 0xffffu); dst[(size_t)(8 * q + 3) * NKEY] = (bf16)(w.y >> 16);
            dst[(size_t)(8 * q + 4) * NKEY] = (bf16)(w.z & 0xffffu); dst[(size_t)(8 * q + 5) * NKEY] = (bf16)(w.z >> 16); dst[(size_t)(8 * q + 6) * NKEY] = (bf16)(w.w & 0xffffu); dst[(size_t)(8 * q + 7) * NKEY] = (bf16)(w.w >> 16); }
    }
}
__device__ __forceinline__ void ph_mix_a(LAS unsigned char* lds, int l, int ntok, const Args& a, const Grp grp) {
    int tid_ = MK_TID(grp); asm volatile("" : "+v"(tid_)); const int tid = tid_, wave = __builtin_amdgcn_readfirstlane(tid >> 6), lane = tid & 63, fr = lane & 15, fq = lane >> 4, G = grp.n, vcu = grp.v;
    const bf16* P = (const bf16*)(a.ws + WS_P); bf16* Y = (bf16*)(a.ws + WS_Y);
    const float* vg = a.in[9] + l * 256; const float* aws = a.in[10] + (size_t)l * 4 * 128 * 128; const float* abs_ = a.in[11] + l * 4 * 128;
    constexpr int VPITCH = 272;
    const int nit = (ntok / 128) * 4;
    const int q = tid >> 2, part = tid & 3, p = wave * 16 + fr;
    int hcur = -1; float vgr[16]; bf16x8_t wf[4]; float bs = 0.f;
    u32x4 w0, w1, n0, n1;
#define MA_LOADV(x0, x1, it) do { const bf16* _vp = P + (size_t)(gtok(grp.g, ((it) >> 2) * 128) + q) * DINP + 256 + ((it) & 3) * 64 + part * 16; x0 = *(const u32x4*)_vp; x1 = *(const u32x4*)(_vp + 8); } while (0)
    if (vcu < nit) MA_LOADV(w0, w1, vcu);
    for (int it = vcu; it < nit; it += G) {
        const int h = it & 3, tokbase = gtok(grp.g, (it >> 2) * 128), tok = tokbase + p;
        u32x2 uw[4];
#pragma unroll
        for (int cb = 0; cb < 4; ++cb) uw[cb] = *(const u32x2*)(P + (size_t)tok * DINP + h * 64 + 16 * cb + 4 * fq);
        if (h != hcur) { hcur = h;
#pragma unroll
            for (int i = 0; i < 16; ++i) vgr[i] = vg[h * 64 + part * 16 + i];
            const float* wrow = aws + ((size_t)h * 128 + p) * 128;
#pragma unroll
            for (int ks = 0; ks < 4; ++ks) { const f32x4 wa = *(const f32x4*)(wrow + 32 * ks + 8 * fq), wb = *(const f32x4*)(wrow + 32 * ks + 8 * fq + 4);
                u32x4 wp; wp.x = pk2(wa.x, wa.y); wp.y = pk2(wa.z, wa.w); wp.z = pk2(wb.x, wb.y); wp.w = pk2(wb.z, wb.w); wf[ks] = __builtin_bit_cast(bf16x8_t, wp); }
            bs = abs_[h * 128 + p]; }
        __syncthreads();
        {
            float v[16] = {blo(w0.x), bhi(w0.x), blo(w0.y), bhi(w0.y), blo(w0.z), bhi(w0.z), blo(w0.w), bhi(w0.w), blo(w1.x), bhi(w1.x), blo(w1.y), bhi(w1.y), blo(w1.z), bhi(w1.z), blo(w1.w), bhi(w1.w)};
            float ss = 0.f;
#pragma unroll
            for (int i = 0; i < 16; ++i) { v[i] = gelu_tanh(v[i]); ss += v[i] * v[i]; }
            ss += __shfl_xor(ss, 1); ss += __shfl_xor(ss, 2);
            const float rstd = rsqrtf(ss * (1.f / 64.f) + EPS);
#pragma unroll
            for (int i = 0; i < 16; ++i) { const int c = part * 16 + i; *(LAS bf16*)(lds + c * VPITCH + q * 2) = f2bf(v[i] * rstd * vgr[i]); }
        }
        __syncthreads();
        if (it + G < nit) MA_LOADV(n0, n1, it + G);
        {
            f32x4 acc[4];
#pragma unroll
            for (int cb = 0; cb < 4; ++cb) acc[cb] = (f32x4){0.f, 0.f, 0.f, 0.f};
#pragma unroll
            for (int ks = 0; ks < 4; ++ks) {
#pragma unroll
                for (int cb = 0; cb < 4; ++cb) {
                    const bf16x8_t vf = *(const LAS bf16x8_t*)(lds + (16 * cb + fr) * VPITCH + (32 * ks + 8 * fq) * 2);
                    acc[cb] = __builtin_amdgcn_mfma_f32_16x16x32_bf16(vf, wf[ks], acc[cb], 0, 0, 0);
                }
            }
#pragma unroll
            for (int cb = 0; cb < 4; ++cb) {
                const int c = h * 64 + 16 * cb + 4 * fq;
                u32x2 o; o.x = pk2(gelu_tanh(blo(uw[cb].x)) * (acc[cb][0] + bs), gelu_tanh(bhi(uw[cb].x)) * (acc[cb][1] + bs)); o.y = pk2(gelu_tanh(blo(uw[cb].y)) * (acc[cb][2] + bs), gelu_tanh(bhi(uw[cb].y)) * (acc[cb][3] + bs));
                *(u32x2*)(Y + (size_t)tok * D + c) = o;
            }
        }
        w0 = n0; w1 = n1;
    }
#undef MA_LOADV
    __syncthreads();
}

__device__ __forceinline__ void ph_mix_c(LAS unsigned char* lds, int l, int ntok, const Args& a, const Grp grp) {
    int tid_ = MK_TID(grp); asm volatile("" : "+v"(tid_)); const int tid = tid_, wave = __builtin_amdgcn_readfirstlane(tid >> 6), lane = tid & 63, G = grp.n, vcu = grp.v;
    const bf16* P = (const bf16*)(a.ws + WS_P); bf16* Y = (bf16*)(a.ws + WS_Y);
    const float* cw = a.in[19] + l * 31 * 256; const float* cb = a.in[20] + l * 256; const float* lg = a.in[21] + l * 256; const float* lb = a.in[22] + l * 256;
    LAS float* zs = (LAS float*)lds;
    LAS float* wl = (LAS float*)(lds + 96256);
    __syncthreads();
    for (int i = tid; i < 31 * 256; i += 512) wl[i] = cw[i];
    float gv[4], bv[4], cbv[4];
#pragma unroll
    for (int hp = 0; hp < 2; ++hp)
#pragma unroll
        for (int e = 0; e < 2; ++e) { const int c = hp * 128 + 2 * lane + e; gv[2 * hp + e] = lg[c]; bv[2 * hp + e] = lb[c]; cbv[2 * hp + e] = cb[c]; }
    const int nit = ntok / 64;
    u32x4 zr[6];
#define MC_LOADZ(item) do { const int _tok0 = gtok(grp.g, (item) * 64); int _s0, _len; if (_tok0 < NLAT) { _s0 = _tok0 & ~2047; _len = 2048; } else { _s0 = NLAT + ((_tok0 - NLAT) & ~255); _len = 256; } \
        _Pragma("unroll") for (int k = 0; k < 6; ++k) { const int idx = tid + 512 * k, r = idx >> 5, c8 = (idx & 31) * 8, pos = _tok0 - _s0 - 15 + r; zr[k] = (u32x4){0u, 0u, 0u, 0u}; \
            if (idx < 94 * 32 && pos >= 0 && pos < _len) zr[k] = *(const u32x4*)(P + (size_t)(_s0 + pos) * DINP + 1280 + c8); } } while (0)
    for (int item = G - 1 - vcu; item < nit; item += G) {
        const int tok0 = gtok(grp.g, item * 64);
        MC_LOADZ(item);
        __syncthreads();
#pragma unroll
        for (int k = 0; k < 6; ++k) { const int idx = tid + 512 * k, r = idx >> 5, c8 = (idx & 31) * 8;
            if (idx < 94 * 32) { const u32x4 zz = zr[k];
                *(LAS f32x4*)(zs + r * 256 + c8) = (f32x4){blo(zz.x), bhi(zz.x), blo(zz.y), bhi(zz.y)}; *(LAS f32x4*)(zs + r * 256 + c8 + 4) = (f32x4){blo(zz.z), bhi(zz.z), blo(zz.w), bhi(zz.w)}; } }
        __syncthreads();
        float res[8][4];
#pragma unroll
        for (int hp = 0; hp < 2; ++hp) {
            const int c = hp * 128 + 2 * lane;
            float w0[31], w1[31];
#pragma unroll
            for (int j = 0; j < 31; ++j) { const f32x2 w = *(const LAS f32x2*)(wl + j * 256 + c); w0[j] = w.x; w1[j] = w.y; }
            float a0[8], a1[8];
#pragma unroll
            for (int r = 0; r < 8; ++r) { a0[r] = cbv[2 * hp]; a1[r] = cbv[2 * hp + 1]; }
#pragma unroll
            for (int rr = 0; rr < 38; ++rr) {
                const f32x2 z = *(const LAS f32x2*)(zs + (8 * wave + rr) * 256 + c);
#pragma unroll
                for (int r = 0; r < 8; ++r) { const int j = rr - r; if (j >= 0 && j < 31) { a0[r] += z.x * w0[j]; a1[r] += z.y * w1[j]; } }
            }
#pragma unroll
            for (int r = 0; r < 8; ++r) { res[r][2 * hp] = a0[r]; res[r][2 * hp + 1] = a1[r]; }
        }
#pragma unroll
        for (int r = 0; r < 8; ++r) {
            const float mean = wave_sum(res[r][0] + res[r][1] + res[r][2] + res[r][3]) * (1.f / 256.f);
            const float d0 = res[r][0] - mean, d1 = res[r][1] - mean, d2 = res[r][2] - mean, d3 = res[r][3] - mean;
            const float rstd = rsqrtf(wave_sum(d0 * d0 + d1 * d1 + d2 * d2 + d3 * d3) * (1.f / 256.f) + EPS);
            const int tok = tok0 + 8 * wave + r;
            *(unsigned*)(Y + (size_t)tok * D + 512 + 2 * lane) = pk2(silu_f(d0 * rstd * gv[0] + bv[0]), silu_f(d1 * rstd * gv[1] + bv[1]));
            *(unsigned*)(Y + (size_t)tok * D + 512 + 128 + 2 * lane) = pk2(silu_f(d2 * rstd * gv[2] + bv[2]), silu_f(d3 * rstd * gv[3] + bv[3]));
        }
    }
#undef MC_LOADZ
    __syncthreads();
}

__device__ __forceinline__ void ph_mix_d(int l, int ntok, const Args& a, const Grp grp) {
    const bf16* P = (const bf16*)(a.ws + WS_P); bf16* Y = (bf16*)(a.ws + WS_Y); const float* dw = a.in[23] + l * 3 * 256;
    int tid_ = MK_TID(grp); asm volatile("" : "+v"(tid_));
    const int c8 = (tid_ & 31) * 8, rid = grp.v * 16 + (tid_ >> 5), nruns = grp.n * 16;
    constexpr int CH = 9;
    const int R = (ntok + nruns - 1) / nruns, t0 = rid * R, t1 = (t0 + R < ntok) ? t0 + R : ntok;
    f32x4 wa[3], wb[3];
#pragma unroll
    for (int j = 0; j < 3; ++j) { wa[j] = *(const f32x4*)(dw + j * 256 + c8); wb[j] = *(const f32x4*)(dw + j * 256 + c8 + 4); }
    for (int tc = t0; tc < t1; tc += CH) {
        u32x4 dd[CH + 2], db[CH];
#pragma unroll
        for (int i = 0; i < CH + 2; ++i) { int t = tc - 1 + i; t = t < 0 ? 0 : (t >= ntok ? ntok - 1 : t); dd[i] = *(const u32x4*)(P + (size_t)gtok(grp.g, t) * DINP + 1792 + c8); }
#pragma unroll
        for (int i = 0; i < CH; ++i) { int t = tc + i; t = t >= ntok ? ntok - 1 : t; db[i] = *(const u32x4*)(P + (size_t)gtok(grp.g, t) * DINP + 1536 + c8); }
#pragma unroll
        for (int i = 0; i < CH; ++i) {
            const int t = tc + i;
            if (t < t1) {
                const int tok = gtok(grp.g, t);
                int s0, len; if (tok < NLAT) { s0 = tok & ~2047; len = 2048; } else { s0 = NLAT + ((tok - NLAT) & ~255); len = 256; }
                const int pos = tok - s0;
                float acc[8];
#pragma unroll
                for (int k = 0; k < 8; ++k) acc[k] = 0.f;
#pragma unroll
                for (int j = 0; j < 3; ++j) { const int pp = pos + j - 1;
                    if (pp >= 0 && pp < len) { const u32x4 d = dd[i + j];
                        acc[0] += blo(d.x) * wa[j].x; acc[1] += bhi(d.x) * wa[j].y; acc[2] += blo(d.y) * wa[j].z; acc[3] += bhi(d.y) * wa[j].w;
                        acc[4] += blo(d.z) * wb[j].x; acc[5] += bhi(d.z) * wb[j].y; acc[6] += blo(d.w) * wb[j].z; acc[7] += bhi(d.w) * wb[j].w; } }
                const u32x4 b = db[i];
                u32x4 o; o.x = pk2(blo(b.x) * acc[0], bhi(b.x) * acc[1]); o.y = pk2(blo(b.y) * acc[2], bhi(b.y) * acc[3]); o.z = pk2(blo(b.z) * acc[4], bhi(b.z) * acc[5]); o.w = pk2(blo(b.w) * acc[6], bhi(b.w) * acc[7]);
                *(u32x4*)(Y + (size_t)tok * D + 768 + c8) = o;
            }
        }
    }
}

__device__ __forceinline__ void ph_attn(LAS unsigned char* lds, int l, const Args& a, const Grp grp) {
    int tid_ = MK_TID(grp); asm volatile("" : "+v"(tid_)); const int tid = tid_, wid = __builtin_amdgcn_readfirstlane(tid >> 6), lane = tid & 63, fr = lane & 15, fq = lane >> 4, G = grp.n, vcu = grp.v;
    const bf16* P = (const bf16*)(a.ws + WS_P); bf16* Y = (bf16*)(a.ws + WS_Y);
    const float* subln = a.in[18] + l * 64;
    const float lam_init = lam_init_of(l);
    float lam, negM[2];
    { const float d1 = lane < 32 ? a.in[14][l * 32 + lane] * a.in[15][l * 32 + lane] : 0.f, d2 = lane < 32 ? a.in[16][l * 32 + lane] * a.in[17][l * 32 + lane] : 0.f;
      lam = __expf(wave_sum(d1)) - __expf(wave_sum(d2)) + lam_init;
#pragma unroll
      for (int m = 0; m < 2; ++m) { const float mq = wave_max(lane < 32 ? fabsf(a.in[12][l * 64 + m * 32 + lane]) : 0.f), mk = wave_max(lane < 32 ? fabsf(a.in[13][l * 64 + m * 32 + lane]) : 0.f); negM[m] = -8.2433f * mq * mk; } }
    const int nunits = (l == 0) ? 256 + 32 : 256;
    const int prow = (wid * 64 + lane) >> 3, pch = (lane & 7) ^ (prow & 7);
    const int rdsw = fr & 7;
    const int vch = (lane & 7) ^ (2 * ((prow >> 1) & 3));
    const int vq = fr >> 2, vp = fr & 3, vsw = 2 * (2 * (fq & 1) + (vq >> 1));
    const int vrd0 = (4 * fq + vq) * 128 + 8 * (vp & 1);
    if (wid >= 4) __builtin_amdgcn_s_setprio(1);
    for (int u = vcu; u < nunits; u += G) {
        int b, h, qtok0, t0, nt;
        if (u < 256) { b = grp.g * 8 + (u >> 5); h = (u >> 3) & 3; qtok0 = b * 2048 + (u & 7) * 256; t0 = 0; nt = 36; }
        else { const int uc = u - 256; b = grp.g * 8 + (uc >> 2); h = uc & 3; qtok0 = NLAT + b * 256; t0 = 32; nt = 4; }
        bf16x8_t Qf[2][2];
#pragma unroll
        for (int m = 0; m < 2; ++m)
#pragma unroll
            for (int qb = 0; qb < 2; ++qb) Qf[m][qb] = *(const bf16x8_t*)(P + (size_t)(qtok0 + wid * 32 + qb * 16 + fr) * DINP + 512 + h * 64 + m * 32 + 8 * fq);
        f32x4 O[2][4][2], Ls[2][2];
        const bf16x8_t ones = __builtin_bit_cast(bf16x8_t, (u32x4){0x3f803f80u, 0x3f803f80u, 0x3f803f80u, 0x3f803f80u});
#pragma unroll
        for (int m = 0; m < 2; ++m)
#pragma unroll
            for (int qb = 0; qb < 2; ++qb) { Ls[m][qb] = (f32x4){0.f, 0.f, 0.f, 0.f};
#pragma unroll
                for (int eb = 0; eb < 4; ++eb) O[m][eb][qb] = (f32x4){0.f, 0.f, 0.f, 0.f}; }
#define ATT_ISSUE(j) do { const int _t = t0 + (j); const int _kt = _t < 32 ? b * 2048 + _t * 64 : NLAT + b * 256 + (_t - 32) * 64; const int _s = (j) % 3; \
        __builtin_amdgcn_global_load_lds((const unsigned*)(P + (size_t)(_kt + prow) * DINP + 768 + h * 64 + pch * 8), (LAS unsigned*)(lds + _s * 16384 + wid * 1024), 16, 0, 0); \
        __builtin_amdgcn_global_load_lds((const unsigned*)(P + (size_t)(_kt + prow) * DINP + 1024 + h * 64 + vch * 8), (LAS unsigned*)(lds + _s * 16384 + 8192 + wid * 1024), 16, 0, 0); } while (0)
        asm volatile("s_waitcnt lgkmcnt(0)\n\ts_barrier" ::: "memory");
        ATT_ISSUE(0); ATT_ISSUE(1);
        for (int i = 0; i < nt; ++i) {
            if (i + 1 < nt) asm volatile("s_waitcnt vmcnt(2)\n\ts_barrier" ::: "memory"); else asm volatile("s_waitcnt vmcnt(0)\n\ts_barrier" ::: "memory");
            if (i + 2 < nt) ATT_ISSUE(i + 2);
            const LAS unsigned char* Ks = lds + (i % 3) * 16384; const LAS unsigned char* Vs = Ks + 8192;
            bf16x8_t Pf[2][2][2];
#pragma unroll
            for (int m = 0; m < 2; ++m) {
                f32x4 S[4][2];
#pragma unroll
                for (int kb = 0; kb < 4; ++kb) {
                    const bf16x8_t kf = *(const LAS bf16x8_t*)(Ks + (16 * kb + fr) * 128 + (((m * 4 + fq) ^ rdsw) * 16));
#pragma unroll
                    for (int qb = 0; qb < 2; ++qb) S[kb][qb] = __builtin_amdgcn_mfma_f32_16x16x32_bf16(kf, Qf[m][qb], (f32x4){negM[m], negM[m], negM[m], negM[m]}, 0, 0, 0);
                }
#pragma unroll
                for (int qb = 0; qb < 2; ++qb) {
#pragma unroll
                    for (int kb = 0; kb < 4; ++kb) {
#pragma unroll
                        for (int j = 0; j < 4; ++j) S[kb][qb][j] = __builtin_amdgcn_exp2f(S[kb][qb][j]); }
#pragma unroll
                    for (int g = 0; g < 2; ++g) { u32x4 w; w.x = pg8::cvt_pk_bf16(S[2 * g][qb][0], S[2 * g][qb][1]); w.y = pg8::cvt_pk_bf16(S[2 * g][qb][2], S[2 * g][qb][3]);
                        w.z = pg8::cvt_pk_bf16(S[2 * g + 1][qb][0], S[2 * g + 1][qb][1]); w.w = pg8::cvt_pk_bf16(S[2 * g + 1][qb][2], S[2 * g + 1][qb][3]); Pf[m][g][qb] = __builtin_bit_cast(bf16x8_t, w);
                        Ls[m][qb] = __builtin_amdgcn_mfma_f32_16x16x32_bf16(ones, Pf[m][g][qb], Ls[m][qb], 0, 0, 0); }
                }
            }
#pragma unroll
            for (int eb = 0; eb < 4; ++eb)
#pragma unroll
                for (int g = 0; g < 2; ++g) {
                    const int vslot = ((2 * eb + (vp >> 1)) ^ vsw) * 16;
                    const v4i16_t t0 = __builtin_amdgcn_ds_read_tr16_b64_v4i16((LAS v4i16_t*)(Vs + (32 * g) * 128 + vrd0 + vslot)), t1 = __builtin_amdgcn_ds_read_tr16_b64_v4i16((LAS v4i16_t*)(Vs + (32 * g + 16) * 128 + vrd0 + vslot));
                    const bf16x8_t vf = __builtin_shufflevector(t0, t1, 0, 1, 2, 3, 4, 5, 6, 7);
#pragma unroll
                    for (int m = 0; m < 2; ++m)
#pragma unroll
                        for (int qb = 0; qb < 2; ++qb) O[m][eb][qb] = __builtin_amdgcn_mfma_f32_16x16x32_bf16(vf, Pf[m][g][qb], O[m][eb][qb], 0, 0, 0);
                }
        }
#undef ATT_ISSUE
#pragma unroll
        for (int qb = 0; qb < 2; ++qb) {
            const float l1 = Ls[0][qb][0], l2 = Ls[1][qb][0];
            const float r1 = 1.f / l1, r2 = lam / l2;
            f32x4 o[4]; float ss = 0.f;
#pragma unroll
            for (int eb = 0; eb < 4; ++eb) { o[eb] = O[0][eb][qb] * r1 - O[1][eb][qb] * r2; ss += o[eb][0] * o[eb][0] + o[eb][1] * o[eb][1] + o[eb][2] * o[eb][2] + o[eb][3] * o[eb][3]; }
            ss += __shfl_xor(ss, 16); ss += __shfl_xor(ss, 32);
            const float rs = rsqrtf(ss * (1.f / 64.f) + EPS) * (1.f - lam_init);
            bf16* yp = Y + (size_t)(qtok0 + wid * 32 + qb * 16 + fr) * D + 256 + h * 64 + 4 * fq;
#pragma unroll
            for (int eb = 0; eb < 4; ++eb) { const f32x4 g = *(const f32x4*)(subln + 16 * eb + 4 * fq); u32x2 w; w.x = pk2(o[eb][0] * rs * g.x, o[eb][1] * rs * g.y); w.y = pk2(o[eb][2] * rs * g.z, o[eb][3] * rs * g.w);
                *(u32x2*)(yp + 16 * eb) = w; }
        }
    }
    __builtin_amdgcn_s_setprio(0);
    asm volatile("s_waitcnt vmcnt(0) lgkmcnt(0)\n\ts_barrier" ::: "memory");
}

constexpr int RW_PITCH = 2064, RW_PART = NE * RW_PITCH, RW_IMG = 2 * RW_PART;
__device__ __forceinline__ void ph_route(LAS unsigned char* lds, int l, int ntok, const Args& a, const Grp grp) {
    int tid_ = MK_TID(grp); asm volatile("" : "+v"(tid_)); const int tid = tid_, wave = __builtin_amdgcn_readfirstlane(tid >> 6), lane = tid & 63, fr = lane & 15, fq = lane >> 4, G = grp.n, vcu = grp.v;
    const bf16* X = (const bf16*)(a.ws + WS_X); const float* mod = (const float*)(a.ws + WS_MOD); const float* norm_g = a.in[7] + l * D; const float* rb = a.in[26] + l * NE;
    unsigned char* H8 = a.ws + WS_H8; unsigned* cnt = (unsigned*)(a.ws + WS_CTL) + CW_CNT + (grp.g * NL + l) * 64; int* list = (int*)(a.ws + WS_LIST) + (size_t)grp.g * NE * GCAP; float* gate = (float*)(a.ws + WS_GATE);
    const float* SSp = (const float*)(a.ws + WS_SS);
    LAS unsigned* hist = (LAS unsigned*)(lds + LDS_MISC + 4096); LAS unsigned* gbase = hist + NE;
    LAS unsigned short* sel_e = (LAS unsigned short*)(lds + LDS_MISC + 4352); LAS unsigned short* sel_p = sel_e + 1024;
    __syncthreads();
    if (tid < NE) hist[tid] = 0u;
    for (int i = tid; i < 1024; i += 512) sel_e[i] = 0xffffu;
    const int nitems = ntok / 16, ipw = (nitems + G - 1) / G, it0 = vcu * ipw, it1 = (it0 + ipw < nitems) ? it0 + ipw : nitems;
    const int kcol = 128 * wave + 8 * fq;
    bf16x8_t wh[2][4], wl[2][4];
    { const unsigned char* img = a.ws + WS_RWT + (size_t)l * RW_IMG;
#pragma unroll
      for (int nb = 0; nb < 2; ++nb)
#pragma unroll
          for (int ks = 0; ks < 4; ++ks) { const unsigned char* wp = img + (nb * 16 + fr) * RW_PITCH + (kcol + 32 * ks) * 2; wh[nb][ks] = *(const bf16x8_t*)wp; wl[nb][ks] = *(const bf16x8_t*)(wp + RW_PART); } }
    f32x4 ca[4][2], cb[4][2]; int cmr = -1;
    u32x4 xw[4], xn[4]; f32x4 p4, pn4;
#define RT_LOAD(xv, pv, it) do { const int _tok = gtok(grp.g, (it) * 16) + fr; const bf16* _xr = X + (size_t)_tok * D + kcol; \
        _Pragma("unroll") for (int ks = 0; ks < 4; ++ks) xv[ks] = *(const u32x4*)(_xr + 32 * ks); pv = *(const f32x4*)(SSp + (size_t)_tok * 16 + 4 * fq); } while (0)
    if (it0 < it1) RT_LOAD(xw, p4, it0);
    for (int ib = it0; ib < it1; ib += 5) {
        const int ni = (it1 - ib < 5) ? it1 - ib : 5;
        for (int s = 0; s < ni; ++s) {
            const int it = ib + s, tb0 = gtok(grp.g, it * 16), tok = tb0 + fr, mr = tok_modrow(tb0);
            if (it + 1 < it1) RT_LOAD(xn, pn4, it + 1);
            if (mr != cmr) { cmr = mr; const float* mrow = mod + ((size_t)l * 17 + mr) * MODW + kcol; const float* gp = norm_g + kcol;
#pragma unroll
                for (int ks = 0; ks < 4; ++ks)
#pragma unroll
                    for (int hf = 0; hf < 2; ++hf) { const f32x4 g = *(const f32x4*)(gp + 32 * ks + 4 * hf), sh = *(const f32x4*)(mrow + 3 * D + 32 * ks + 4 * hf), sc = *(const f32x4*)(mrow + 4 * D + 32 * ks + 4 * hf);
                        ca[ks][hf] = g * (1.f + sc); cb[ks][hf] = sh; } }
            float ss = (p4.x + p4.y) + (p4.z + p4.w);
            ss += __shfl_xor(ss, 16); ss += __shfl_xor(ss, 32);
            const float rstd = rsqrtf(ss * (1.f / D) + EPS);
            f32x4 acc[2] = {{0.f, 0.f, 0.f, 0.f}, {0.f, 0.f, 0.f, 0.f}};
#pragma unroll
            for (int ks = 0; ks < 4; ++ks) {
                float h[8];
                { const u32x4 w = xw[ks]; const f32x4 x0 = {blo(w.x), bhi(w.x), blo(w.y), bhi(w.y)}, x1 = {blo(w.z), bhi(w.z), blo(w.w), bhi(w.w)};
                  const f32x4 h0 = x0 * rstd * ca[ks][0] + cb[ks][0], h1 = x1 * rstd * ca[ks][1] + cb[ks][1];
                  h[0] = h0.x; h[1] = h0.y; h[2] = h0.z; h[3] = h0.w; h[4] = h1.x; h[5] = h1.y; h[6] = h1.z; h[7] = h1.w; }
                u32x2 w8; { int t = __builtin_amdgcn_cvt_pk_fp8_f32(h[0], h[1], 0, false); t = __builtin_amdgcn_cvt_pk_fp8_f32(h[2], h[3], t, true); w8.x = (unsigned)t;
                            t = __builtin_amdgcn_cvt_pk_fp8_f32(h[4], h[5], 0, false); t = __builtin_amdgcn_cvt_pk_fp8_f32(h[6], h[7], t, true); w8.y = (unsigned)t; }
                *(u32x2*)(H8 + (size_t)tok * D + kcol + 32 * ks) = w8;
                u32x4 hh, hl;
                hh.x = pg8::cvt_pk_bf16(h[0], h[1]); hh.y = pg8::cvt_pk_bf16(h[2], h[3]); hh.z = pg8::cvt_pk_bf16(h[4], h[5]); hh.w = pg8::cvt_pk_bf16(h[6], h[7]);
                hl.x = pg8::cvt_pk_bf16(h[0] - blo(hh.x), h[1] - bhi(hh.x)); hl.y = pg8::cvt_pk_bf16(h[2] - blo(hh.y), h[3] - bhi(hh.y)); hl.z = pg8::cvt_pk_bf16(h[4] - blo(hh.z), h[5] - bhi(hh.z)); hl.w = pg8::cvt_pk_bf16(h[6] - blo(hh.w), h[7] - bhi(hh.w));
                const bf16x8_t fh = __builtin_bit_cast(bf16x8_t, hh), fl = __builtin_bit_cast(bf16x8_t, hl);
#pragma unroll
                for (int nb = 0; nb < 2; ++nb) {
                    acc[nb] = __builtin_amdgcn_mfma_f32_16x16x32_bf16(wh[nb][ks], fh, acc[nb], 0, 0, 0);
                    acc[nb] = __builtin_amdgcn_mfma_f32_16x16x32_bf16(wh[nb][ks], fl, acc[nb], 0, 0, 0);
                    acc[nb] = __builtin_amdgcn_mfma_f32_16x16x32_bf16(wl[nb][ks], fh, acc[nb], 0, 0, 0);
                }
            }
#pragma unroll
            for (int nb = 0; nb < 2; ++nb) *(LAS f32x4*)(lds + ((s * 8 + wave) * 2 + nb) * 1024 + lane * 16) = acc[nb];
#pragma unroll
            for (int ks = 0; ks < 4; ++ks) xw[ks] = xn[ks];
            p4 = pn4;
        }
        __syncthreads();
        if (wave < ni) {
            const int it = ib + wave, tok = gtok(grp.g, it * 16) + fr;
            float lg[8];
#pragma unroll
            for (int nb = 0; nb < 2; ++nb) { f32x4 sum = *(const f32x4*)(rb + 16 * nb + 4 * fq);
#pragma unroll
                for (int w = 0; w < 8; ++w) sum += *(const LAS f32x4*)(lds + ((wave * 8 + w) * 2 + nb) * 1024 + lane * 16);
#pragma unroll
                for (int jj = 0; jj < 4; ++jj) lg[4 * nb + jj] = sum[jj]; }
            float tv[4]; int ti[4];
#pragma unroll
            for (int k = 0; k < 4; ++k) {
                float bv = lg[0]; int bi = 4 * fq;
#pragma unroll
                for (int q = 1; q < 8; ++q) { const int eq = 16 * (q >> 2) + 4 * fq + (q & 3); if (lg[q] > bv) { bv = lg[q]; bi = eq; } }
#pragma unroll
                for (int o = 16; o < 64; o <<= 1) { const float ov = __shfl_xor(bv, o); const int oi = __shfl_xor(bi, o); if (ov > bv || (ov == bv && oi < bi)) { bv = ov; bi = oi; } }
                tv[k] = bv; ti[k] = bi;
#pragma unroll
                for (int q = 0; q < 8; ++q) { const int eq = 16 * (q >> 2) + 4 * fq + (q & 3); if (eq == bi) lg[q] = -3.0e38f; }
            }
            if (fq == 0) {
                const float e1 = __expf(tv[1] - tv[0]), e2 = __expf(tv[2] - tv[0]), e3 = __expf(tv[3] - tv[0]); const float rz = 1.f / (1.f + e1 + e2 + e3);
                *(f32x4*)(gate + (size_t)tok * 4) = (f32x4){rz, e1 * rz, e2 * rz, e3 * rz};
                const int lt = (it - it0) * 16 + fr;
#pragma unroll
                for (int k = 0; k < 4; ++k) { const unsigned lp = __hip_atomic_fetch_add(&hist[ti[k]], 1u, __ATOMIC_RELAXED, __HIP_MEMORY_SCOPE_WORKGROUP); sel_e[lt * 4 + k] = (unsigned short)ti[k]; sel_p[lt * 4 + k] = (unsigned short)lp; }
            }
        }
        __syncthreads();
    }
#undef RT_LOAD
    if (tid < NE) gbase[tid] = __hip_atomic_fetch_add(&cnt[tid], hist[tid], __ATOMIC_RELAXED, __HIP_MEMORY_SCOPE_AGENT);
    __syncthreads();
    for (int i = tid; i < 1024; i += 512) { const int ee = sel_e[i];
        if (ee != 0xffff) { const int lt = i >> 2, tk = gtok(grp.g, (it0 + (lt >> 4)) * 16) + (lt & 15); list[(size_t)ee * GCAP + gbase[ee] + sel_p[i]] = tk * 4 + (i & 3); } }
    __syncthreads();
}

__device__ __forceinline__ void group_tables(LAS int* misc, const unsigned* cnt, const Grp grp) {
    __syncthreads();
    int tid_ = MK_TID(grp); asm volatile("" : "+v"(tid_));
    if (tid_ < 32) misc[64 + tid_] = (int)__hip_atomic_load(cnt + tid_, __ATOMIC_RELAXED, __HIP_MEMORY_SCOPE_AGENT);
    __syncthreads();
    if (tid_ == 0) { int s = 0; for (int e = 0; e < 32; ++e) { misc[e] = s; s += (misc[64 + e] + 255) >> 8; } misc[32] = s; }
    __syncthreads();
}

constexpr int N_PHASES = 2 + 7 * NL;
__global__ void __launch_bounds__(512, 2) mk_fwd(Args a) {
    extern __shared__ __attribute__((aligned(16))) unsigned char lds_raw[];
    LAS unsigned char* lds = (LAS unsigned char*)lds_raw;
    LAS int* misc = (LAS int*)(lds + LDS_MISC);
    const int wv_ = __builtin_amdgcn_readfirstlane((int)threadIdx.x >> 6), G = gridDim.x, bx = blockIdx.x;
#define tid (wv_ * 64 + mk_lane())
    const int vcu = (G % 8 == 0) ? (bx % 8) * (G / 8) + bx / 8 : bx;
    Grp grp;
    if (G % 16 == 0) { grp.g = (bx >> 3) & 1; grp.v = (bx & 7) * (G / 16) + (bx >> 4); grp.c = (bx & 7) + 8 * (bx >> 4); } else { grp.g = bx & 1; grp.v = bx >> 1; grp.c = bx >> 1; }
    grp.n = G / 2; grp.w = wv_;
    if (tid < 4) misc[128 + tid] = 0;
    __syncthreads();
    unsigned* flags = (unsigned*)(a.ws + WS_CTL) + CW_FLAG;
#if MK_PER_PHASE
#define GRID_BAR() do { } while (0)
#define WAIT_FLAG(w) do { } while (0)
#define SET_FLAG(w) do { } while (0)
#else
    XcdBarrier bar = xcd_barrier_post((unsigned*)(a.ws + WS_CTL) + CW_BAR + grp.g * XCD_BAR_WORDS, (volatile LAS unsigned*)(misc + 128), (unsigned)grp.n, (unsigned)wv_);
#define GRID_BAR() xcd_barrier(bar)
#define SET_FLAG(w) do { if (grp.v == 0 && tid == 0) __hip_atomic_store(flags + 64 * (w), 1u, __ATOMIC_RELAXED, __HIP_MEMORY_SCOPE_AGENT); } while (0)
#define WAIT_FLAG(w) do { if (tid == 0) { unsigned sp_ = 0; while (__hip_atomic_load(flags + 64 * (w), __ATOMIC_RELAXED, __HIP_MEMORY_SCOPE_AGENT) == 0u) { __builtin_amdgcn_s_sleep(8); if (++sp_ > (1u << 22)) break; } \
        __builtin_amdgcn_fence(__ATOMIC_ACQUIRE, "agent"); asm volatile("s_waitcnt vmcnt(0)" ::: "memory"); } __syncthreads(); } while (0)
#endif
    const int lo = a.ph_lo, hi = a.ph_hi;
#ifndef PH_MASK
#define PH_MASK 0x3ff
#endif
#define PHM(j) (((PH_MASK) >> (j)) & 1)
#define IN(k) (lo <= (k) && (k) < hi)
#define SEAM(k) do { if ((k) + 1 < hi) GRID_BAR(); } while (0)
    unsigned char* ws = a.ws;
    bf16* H = (bf16*)(ws + WS_H); bf16* P = (bf16*)(ws + WS_P); bf16* Y = (bf16*)(ws + WS_Y); unsigned char* O8 = ws + WS_O; bf16* X = (bf16*)(ws + WS_X);
    unsigned char* HID8 = ws + WS_HID + (size_t)grp.g * GHIDROWS * FF;
    const float* MOD = (const float*)(ws + WS_MOD); const int* LISTG = (const int*)(ws + WS_LIST) + (size_t)grp.g * NE * GCAP;

    if (PHM(0) && IN(0)) {
        constexpr long L0_ITEMS = (long)NE * ((D / 128) * (2 * FF / 32) + (FF / 128) * (D / 32)), L0_SPLIT = (L0_ITEMS * 2) / 3;
        if (grp.g == 0) { ph_prologue(lds, a, grp, 0); if (1 < hi) { GRID_BAR(); SET_FLAG(0); } ph_prologue(lds, a, grp, 1, L0_SPLIT, L0_ITEMS); if (1 < hi) { GRID_BAR(); SET_FLAG(1); WAIT_FLAG(3); } }
        else { ph_prologue(lds, a, grp, 3); ph_prologue(lds, a, grp, 1, 0, L0_SPLIT); if (1 < hi) { GRID_BAR(); SET_FLAG(3); WAIT_FLAG(0); } }
#if MK_PER_PHASE
        if (grp.g == 1) ph_prologue(lds, a, grp, 2);
#endif
    }
    constexpr long L1_EARLY2 = (G1_QHI < 10 && !G1_FP8) ? 1280 : 0;
    constexpr long L1_EARLY = 3072;
    for (int l = 0; l < NL; ++l) {
        const int base = 1 + 7 * l, ntok = l == 0 ? GTOK : GLAT;
        const unsigned* cnt = (const unsigned*)(ws + WS_CTL) + CW_CNT + (grp.g * NL + l) * 64;
        if (PHM(1) && IN(base + 0)) { ph_norm1(l, a, grp); SEAM(base + 0); }
        if (PHM(2) && IN(base + 1)) {
#if G1_FP8
            pg8::DenseOrder S; S.init(H, (const bf16*)(ws + WS_WIN + (size_t)l * DIN * D), GTOK, DIN, D / 2, grp.n, grp.c, grp.g);
            pg8::gemm_phase<pg8::EpiP, pg8::DenseOrder, false, true>(lds, D / 2, S, pg8::EpiP{P, a.in[12] + l * 64, (long)(a.in[13] - a.in[12])}, grp.w);
#else
            if (G1_QLO > 0) { pg8::DenseOrder S; S.init(H, (const bf16*)(ws + WS_WIN) + (size_t)l * DIN * D, GTOK, G1_QLO * 256, D, grp.n, grp.c, grp.g);
              pg8::gemm_phase<pg8::EpiPT<false, 0>, pg8::DenseOrder, false>(lds, D, S, pg8::EpiPT<false, 0>{P, a.in[12] + l * 64, (long)(a.in[13] - a.in[12])}, grp.w); }
            if (DINQ > 0) { pg8::DenseOrder S; S.init((const bf16*)(ws + WS_HQ), (const bf16*)(ws + WS_WINQ + (size_t)l * DINQ * D), GTOK, DINQ, D / 2, grp.n, grp.c, grp.g);
              pg8::gemm_phase<pg8::EpiPT<true, G1_QLO>, pg8::DenseOrder, false, true>(lds, D / 2, S, pg8::EpiPT<true, G1_QLO>{P, a.in[12] + l * 64, (long)(a.in[13] - a.in[12])}, grp.w); }
            if (G1_QHI < 10) { pg8::DenseOrder S; S.init(H, (const bf16*)(ws + WS_WIN) + (size_t)l * DIN * D + (size_t)G1_QHI * 256 * D, GTOK, (10 - G1_QHI) * 256, D, grp.n, grp.c, grp.g);
              pg8::gemm_phase<pg8::EpiPT<false, G1_QHI>, pg8::DenseOrder, false>(lds, D, S, pg8::EpiPT<false, G1_QHI>{P, a.in[12] + l * 64, (long)(a.in[13] - a.in[12])}, grp.w); }
#endif
#if !MK_PER_PHASE && !G1_FP8
            if (l == 1 && lo == 0 && G1_QHI < 10) { const int nun = (GTOK / 256) * (10 - G1_QHI), busy = nun % grp.n;
                if (busy != 0 && grp.c >= busy) { Grp gq = grp; gq.v = grp.c - busy; gq.n = grp.n - busy; __syncthreads(); ph_prologue(lds, a, gq, 2, 2 * L1_EARLY + (long)grp.g * L1_EARLY2, 2 * L1_EARLY + (long)(grp.g + 1) * L1_EARLY2); } }
#endif
            SEAM(base + 1);
#if !MK_PER_PHASE && !G1_FP8
            if (l == 1 && lo == 0 && G1_QHI < 10) SET_FLAG(5 + grp.g);
#endif
        }
        if (PHM(3) && IN(base + 2)) { ph_attn(lds, l, a, grp); ph_mix_a(lds, l, ntok, a, grp); ph_mix_c(lds, l, ntok, a, grp); ph_mix_d(l, ntok, a, grp); SEAM(base + 2); }
        if (PHM(5) && IN(base + 3)) {
            pg8::DenseOrder S; S.init(Y, (const bf16*)(ws + WS_WOUT) + (size_t)l * D * D, ntok, D, D, grp.n, grp.c, grp.g);
            pg8::gemm_phase<pg8::EpiX, pg8::DenseOrder, false>(lds, D, S, pg8::EpiX{X, l == 0 ? (const void*)a.in[0] : (const void*)X, l == 0 ? (const void*)a.in[2] : (const void*)(X + (size_t)NLAT * D), MOD + (size_t)l * 17 * MODW + 2 * D, (float*)(ws + WS_SS), l == 0 ? 1 : 0}, grp.w);
#if !MK_PER_PHASE
            if (l == 0 && lo == 0) { const int nun = (ntok / 256) * (D / 256), busy = nun % grp.n;
                if (busy != 0 && grp.c >= busy) { Grp gq = grp; gq.v = grp.c - busy; gq.n = grp.n - busy; __syncthreads(); ph_prologue(lds, a, gq, 2, (long)grp.g * L1_EARLY, (long)(grp.g + 1) * L1_EARLY); } }
#endif
            SEAM(base + 3);
#if !MK_PER_PHASE
            if (l == 0 && lo == 0 && grp.g == 0) SET_FLAG(4);
#endif
        }
        if (PHM(6) && IN(base + 4)) { ph_route(lds, l, ntok, a, grp); SEAM(base + 4); }
        if (PHM(7) && IN(base + 5)) {
            if (lo == 0) { if (l == 0 && grp.g == 1) WAIT_FLAG(1); if (l == 1 && grp.g == 0) { WAIT_FLAG(2); WAIT_FLAG(6); } if (l == 1 && grp.g == 1) { WAIT_FLAG(4); WAIT_FLAG(5); } }
            group_tables(misc, cnt, grp);
            pg8::GroupOrder S{misc, misc + 64, (const char*)(ws + WS_H8), (const char*)(ws + WS_WGU) + (size_t)l * NE * 2 * FF * D, LISTG, (size_t)2 * FF * D, D / 2, 8, grp.n, grp.v, true};
            pg8::gemm_phase<pg8::EpiHid, pg8::GroupOrder, true, true>(lds, D / 2, S, pg8::EpiHid{(bf16*)HID8, a.in[28] + (size_t)l * NE * 2 * FF, misc}, grp.w, misc + 256);
            SEAM(base + 5);
        }
        if (PHM(8) && IN(base + 6)) {
            group_tables(misc, cnt, grp);
            pg8::GroupOrder S{misc, misc + 64, (const char*)HID8, (const char*)(ws + WS_WDN) + (size_t)l * NE * D * FF, LISTG, (size_t)D * FF, FF / 2, 4, grp.n, grp.v, false};
            pg8::gemm_phase<pg8::EpiO, pg8::GroupOrder, false, true>(lds, FF / 2, S, pg8::EpiO{O8, a.in[30] + (size_t)l * NE * D}, grp.w, misc + 256);
#if !MK_PER_PHASE
            if (l == 0 && grp.g == 1 && lo == 0) { __syncthreads(); ph_prologue(lds, a, grp, 2, 2 * L1_EARLY + 2 * L1_EARLY2); }
#endif
            SEAM(base + 6);
#if !MK_PER_PHASE
            if (l == 0 && grp.g == 1 && lo == 0) SET_FLAG(2);
#endif
        }
    }
    if (PHM(9) && IN(N_PHASES - 1)) ph_final(a, grp);
#undef IN
#undef SEAM
#undef GRID_BAR
#undef tid
}

extern "C" void kernel_launch(void* const* d_in, const int* in_sizes, int n_in, void* d_out, int out_size, void* d_ws, size_t ws_size, hipStream_t stream) {
    static int grid = 0;
    if (grid == 0) {
        if (n_in != 31 || ws_size < WS_END || out_size != NLAT * D) { fprintf(stderr, "kernel_launch: unexpected shapes (n_in %d, ws %zu, out %d)\n", n_in, ws_size, out_size); grid = -1; return; }
        int dev = 0, cus = 0, per_cu = 0;
        if (hipGetDevice(&dev) != hipSuccess || hipDeviceGetAttribute(&cus, hipDeviceAttributeMultiprocessorCount, dev) != hipSuccess || cus <= 0) { fprintf(stderr, "kernel_launch: device query failed\n"); grid = -1; return; }
        if (hipFuncSetAttribute((const void*)mk_fwd, hipFuncAttributeMaxDynamicSharedMemorySize, LDS_BYTES) != hipSuccess) { fprintf(stderr, "kernel_launch: hipFuncSetAttribute failed\n"); grid = -1; return; }
        if (hipOccupancyMaxActiveBlocksPerMultiprocessor(&per_cu, (const void*)mk_fwd, 512, LDS_BYTES) != hipSuccess || per_cu < 1) { fprintf(stderr, "kernel_launch: occupancy query reports %d workgroups per CU\n", per_cu); (void)hipGetLastError(); }
        grid = cus & ~15;
    }
    if (grid < 0) return;
    (void)hipMemsetAsync((unsigned char*)d_ws + WS_CTL, 0, CTL_BYTES, stream);
    Args a{};
    for (int i = 0; i < 31; ++i) a.in[i] = (const float*)d_in[i];
    a.out = (float*)d_out; a.ws = (unsigned char*)d_ws;
#if MK_PER_PHASE
    for (int p = 0; p < N_PHASES; ++p) { a.ph_lo = p; a.ph_hi = p + 1; hipLaunchKernelGGL(mk_fwd, dim3(grid), dim3(512), LDS_BYTES, stream, a); }
#else
    a.ph_lo = 0; a.ph_hi = N_PHASES;
    hipLaunchKernelGGL(mk_fwd, dim3(grid), dim3(512), LDS_BYTES, stream, a);
#endif
}
```

```cpp
#include <hip/hip_runtime.h>
#include <cstdio>
#include <cstdint>
#ifndef G1_FP8
#define G1_FP8 0
#endif
#ifndef G1_QLO
#define G1_QLO 0
#define G1_QHI 7
#endif
#ifndef G2_FP8_L1
#define G2_FP8_L1 1
#endif
#ifndef MK_PER_PHASE
#define MK_PER_PHASE 0
#endif

typedef unsigned short bf16;
typedef float f32x4 __attribute__((ext_vector_type(4)));
typedef float f32x2 __attribute__((ext_vector_type(2)));
typedef unsigned u32x4 __attribute__((ext_vector_type(4)));
typedef unsigned u32x2 __attribute__((ext_vector_type(2)));
typedef short bf16x8_t __attribute__((ext_vector_type(8)));
typedef short v4i16_t __attribute__((ext_vector_type(4)));

constexpr int D = 1024, NB = 16, SEQ = 2048, NL = 2, CTXL = 256;
constexpr int NLAT = NB * SEQ, NCTX = NB * CTXL, NTOK = NLAT + NCTX;
constexpr int GW = 256, DIN = 2560, NE = 32, TOPK = 4, FF = 1024;
constexpr int DINP = 2048;
constexpr int NSLOT = NTOK * TOPK;
constexpr int HIDROWS = NSLOT + NE * 256;
constexpr int CAP = NTOK;
constexpr int NKEY = SEQ + CTXL;
constexpr float EPS = 1e-6f;
constexpr int NGRP = 2, GLAT = NLAT / NGRP, GCTX = NCTX / NGRP, GTOK = GLAT + GCTX, GCAP = GTOK, GHIDROWS = GTOK * TOPK + NE * 256;
struct Grp { int g, v, n, c, w; };
__device__ __forceinline__ int mk_lane() { int r; asm volatile("v_mbcnt_lo_u32_b32 %0, -1, 0\n\tv_mbcnt_hi_u32_b32 %0, -1, %0" : "=v"(r)); return r; }
#define MK_TID(grp) ((grp).w * 64 + mk_lane())
constexpr int MODW = 6 * D;

constexpr size_t MiB = 1u << 20;
constexpr size_t WS_CTL = 0, CTL_BYTES = 1 * MiB;
constexpr size_t WS_MOD = 1 * MiB;
constexpr size_t WS_X = 2 * MiB;
constexpr size_t WS_H = WS_X + 144 * MiB;
constexpr size_t WS_HQ = WS_X + 108 * MiB;
constexpr size_t WS_H8 = WS_X + 72 * MiB;
constexpr size_t WS_P = WS_H + 72 * MiB;
constexpr size_t WS_Y = WS_P + 180 * MiB;
constexpr size_t WS_HID = WS_Y + 72 * MiB;
constexpr size_t WS_O = WS_HID + 304 * MiB;
constexpr size_t WS_LIST = WS_O + 288 * MiB;
constexpr size_t WS_GATE = WS_LIST + 5 * MiB;
constexpr size_t WS_WIN = WS_GATE + 1 * MiB;
constexpr size_t WS_WOUT = WS_WIN + 10 * MiB;
constexpr size_t WS_WGU = WS_WOUT + 4 * MiB;
constexpr size_t WS_WDN = WS_WGU + 256 * MiB;
constexpr int DINQ = (G1_QHI - G1_QLO) * 256;
constexpr size_t WS_WINQ = WS_WDN + 128 * MiB;
constexpr size_t WS_WOUTQ = WS_WDN + 128 * MiB + 4 * MiB;
constexpr size_t WS_Y8 = WS_P + 144 * MiB;
constexpr size_t WS_VT = WS_WDN + 128 * MiB;
constexpr size_t WS_RWT = WS_VT + 20 * MiB;
constexpr size_t WS_SS = WS_RWT + 1 * MiB;
constexpr size_t WS_END = WS_SS + 3 * MiB;
constexpr int CW_CNT = 64;
constexpr int CW_BAR = 4096;
constexpr int CW_FLAG = 2048;

__device__ __forceinline__ float bf2f(bf16 v) { return __uint_as_float(((unsigned)v) << 16); }
__device__ __forceinline__ bf16 f2bf(float f) { unsigned u = __float_as_uint(f); return (bf16)((u + 0x7fffu + ((u >> 16) & 1u)) >> 16); }
__device__ __forceinline__ unsigned pk2(float lo, float hi) { return (unsigned)f2bf(lo) | ((unsigned)f2bf(hi) << 16); }
__device__ __forceinline__ float blo(unsigned w) { return __uint_as_float(w << 16); }
__device__ __forceinline__ float bhi(unsigned w) { return __uint_as_float(w & 0xffff0000u); }
__device__ __forceinline__ float sigmoid_f(float x) { return __builtin_amdgcn_rcpf(1.f + __builtin_amdgcn_exp2f(-1.44269504089f * x)); }
__device__ __forceinline__ float silu_f(float x) { return x * sigmoid_f(x); }
__device__ __forceinline__ float gelu_tanh(float x) { const float u = 0.7978845608f * (x + 0.044715f * x * x * x); return x * sigmoid_f(2.f * u); }
__device__ __forceinline__ int tok_modrow(int tok) { return tok < NLAT ? (tok >> 11) : 16; }
__device__ __forceinline__ int gtok(int g, int t) { return t < GLAT ? g * GLAT + t : NLAT + g * GCTX + (t - GLAT); }
__device__ __forceinline__ float wave_sum(float v) {
#pragma unroll
    for (int o = 1; o < 64; o <<= 1) v += __shfl_xor(v, o);
    return v;
}
__device__ __forceinline__ float wave_max(float v) {
#pragma unroll
    for (int o = 1; o < 64; o <<= 1) v = fmaxf(v, __shfl_xor(v, o));
    return v;
}
__device__ __forceinline__ float lam_init_of(int l) { return l == 0 ? 0.2f : 0.35550906f; }
#define LDS_WAIT() asm volatile("s_waitcnt lgkmcnt(0)" ::: "memory")
#define VM_WAIT() asm volatile("s_waitcnt vmcnt(0)" ::: "memory")

#define LAS __attribute__((address_space(3)))
#ifndef PG8_ALIGN_DEFAULT
#define PG8_ALIGN_DEFAULT true
#endif
namespace pg8 {
typedef short bf16x8 __attribute__((ext_vector_type(8)));
typedef int v4i_t __attribute__((ext_vector_type(4)));
typedef int v8i_t __attribute__((ext_vector_type(8)));
constexpr int BM = 256, BK = 64, HALF = 128, HTB = HALF * BK * 2, STAGE_BYTES = 8 * HTB;
__host__ __device__ __forceinline__ int lds_byte(int r, int c) { const int st = (r >> 4) * 2 + (c >> 5), rr = r & 15, cc = c & 31, ob = rr * 64 + cc * 2; return st * 1024 + (ob ^ (((ob >> 9) & 1) << 5)); }
__host__ __device__ __forceinline__ void stage_rc(int b, int& R, int& C) { const int st = b / 1024, sb = b % 1024, swz = sb ^ (((sb >> 9) & 1) << 5); R = (st >> 1) * 16 + swz / 64; C = (st & 1) * 32 + (swz % 64) / 2; }
__host__ __device__ __forceinline__ int perm32(int rho) { const int n = rho >> 4, i = rho & 15; return 8 * (i >> 2) + 4 * n + (i & 3); }
__device__ __forceinline__ void mfma_fp8(f32x4& acc, const v8i_t& b, const v8i_t& a, int sc) {
    asm volatile("v_mfma_scale_f32_16x16x128_f8f6f4 %0, %1, %2, %0, %3, %3 op_sel_hi:[0,0,0]" : "+v"(acc) : "v"(b), "v"(a), "v"(sc));
}
__device__ __forceinline__ void glds16_s(const void* sbase, unsigned voff, unsigned lds_dst) {
    unsigned keep;
    asm volatile("s_mov_b32 %0, m0\n\ts_mov_b32 m0, %3\n\ts_nop 0\n\tglobal_load_lds_dwordx4 %1, %2\n\ts_mov_b32 m0, %0" : "=&s"(keep) : "v"(voff), "s"(sbase), "s"(lds_dst) : "memory");
}
__device__ __forceinline__ unsigned cvt_pk_bf16(float lo, float hi) { unsigned r; asm volatile("v_cvt_pk_bf16_f32 %0, %1, %2" : "=v"(r) : "v"(lo), "v"(hi)); return r; }

struct GU { const char* a; const char* b; const int* rows; const LAS int* tab; int pm, pn, e, nvalid; };

template <class Epi, class Sched, bool GATHER, bool FP8 = false, int STAGGER = 0, bool ALIGN = PG8_ALIGN_DEFAULT>
__device__ __forceinline__ void gemm_phase(LAS unsigned char* lds, const int K, const Sched& S, const Epi& E, const int wv, LAS int* rowtab = nullptr) {
    int tid_ = wv * 64 + mk_lane(); asm volatile("" : "+v"(tid_));
    const int tid = tid_, wid = __builtin_amdgcn_readfirstlane(tid >> 6), lane = tid & 63, wr = wid >> 2, wc = wid & 3, fr = lane & 15, fq = lane >> 4;
    const int nt = K / BK;
    unsigned voffB[2];
#pragma unroll
    for (int i = 0; i < 2; ++i) { int R_, C_; stage_rc(tid * 16 + i * 8192, R_, C_); const int Rb = Epi::PERM ? ((R_ & ~31) + perm32(R_ & 31)) : R_; voffB[i] = (unsigned)(Rb * K + C_) * 2u; }
    const size_t kstep = (size_t)(BK * 2), hstep = (size_t)HALF * K * 2;
    const unsigned ldsb = (unsigned)__builtin_amdgcn_readfirstlane((int)(unsigned)(size_t)lds + wid * 1024);
    const int aoff = lds_byte(wr * 64 + fr, fq * 8), boff = lds_byte(wc * 32 + fr, fq * 8);
#define PG8_SA(b, h) (((b) * 2 + (h)) * HTB)
#define PG8_SB(b, h) ((4 + (b) * 2 + (h)) * HTB)
#define PG8_STAGE(bufoff, gbase, voff) do { _Pragma("unroll") for (int _i = 0; _i < 2; ++_i) \
        glds16_s((const void*)(gbase), (voff)[_i], ldsb + (unsigned)((bufoff) + _i * 8192)); } while (0)
#define PG8_LDA(dst, b, h) do { _Pragma("unroll") for (int m = 0; m < 4; ++m) dst[m] = __builtin_shufflevector(*(const LAS v4i_t*)(lds + PG8_SA(b, h) + aoff + m * 2048), *(const LAS v4i_t*)(lds + PG8_SA(b, h) + aoff + m * 2048 + 1024), 0, 1, 2, 3, 4, 5, 6, 7); } while (0)
#define PG8_LDB(dst, b, h) do { _Pragma("unroll") for (int n = 0; n < 2; ++n) dst[n] = __builtin_shufflevector(*(const LAS v4i_t*)(lds + PG8_SB(b, h) + boff + n * 2048), *(const LAS v4i_t*)(lds + PG8_SB(b, h) + boff + n * 2048 + 1024), 0, 1, 2, 3, 4, 5, 6, 7); } while (0)
#define PG8_MMA(ai, bj, At, Bt) do { __builtin_amdgcn_s_setprio(1); _Pragma("unroll") for (int m = 0; m < 4; ++m) _Pragma("unroll") for (int n = 0; n < 2; ++n) { \
        if (FP8) mfma_fp8(acc[ai][bj][m][n], Bt[n], At[m], sc8); \
        else { acc[ai][bj][m][n] = __builtin_amdgcn_mfma_f32_16x16x32_bf16(__builtin_bit_cast(bf16x8, __builtin_shufflevector(Bt[n], Bt[n], 0, 1, 2, 3)), __builtin_bit_cast(bf16x8, __builtin_shufflevector(At[m], At[m], 0, 1, 2, 3)), acc[ai][bj][m][n], 0, 0, 0); \
               acc[ai][bj][m][n] = __builtin_amdgcn_mfma_f32_16x16x32_bf16(__builtin_bit_cast(bf16x8, __builtin_shufflevector(Bt[n], Bt[n], 4, 5, 6, 7)), __builtin_bit_cast(bf16x8, __builtin_shufflevector(At[m], At[m], 4, 5, 6, 7)), acc[ai][bj][m][n], 0, 0, 0); } } __builtin_amdgcn_s_setprio(0); } while (0)
#define PG8_WAIT_V(n) asm volatile("s_waitcnt vmcnt(" #n ")" ::: "memory")
#define PG8_WAIT_L(n) asm volatile("s_waitcnt lgkmcnt(" #n ")" ::: "memory")
#define PG8_BAR __builtin_amdgcn_s_barrier()
#define PG8_SCHED __builtin_amdgcn_sched_barrier(0)
#define PG8_AOFF(dst, u) do { _Pragma("unroll") for (int _h = 0; _h < 2; ++_h) _Pragma("unroll") for (int _i = 0; _i < 2; ++_i) { int _R, _C; stage_rc(tid * 16 + _i * 8192, _R, _C); \
        if (GATHER) { int _r = _h * HALF + _R; _r = _r < (u).nvalid ? _r : (u).nvalid - 1; dst[_h][_i] = ((unsigned)((u).tab[_r] >> 2) * (unsigned)K + (unsigned)_C) * 2u; } \
        else dst[_h][_i] = (unsigned)(_R * K + _C) * 2u; } } while (0)
#define PG8_AH(h) (GATHER ? (size_t)0 : (size_t)(h) * hstep)
    GU cur, nxt; int ui = 0;
    if (!S.next(0, cur)) return;
    for (int s_ = 0; s_ < (S.c & 7) * STAGGER; ++s_) __builtin_amdgcn_s_sleep(56);
    f32x4 acc[2][2][4][2];
#pragma unroll
    for (int a = 0; a < 2; ++a)
#pragma unroll
        for (int b = 0; b < 2; ++b)
#pragma unroll
            for (int m = 0; m < 4; ++m)
#pragma unroll
                for (int n = 0; n < 2; ++n) acc[a][b][m][n] = (f32x4){0.f, 0.f, 0.f, 0.f};
    v8i_t At[4], B0[2], B1[2];
    typename Epi::Pre pre;
    int sc8 = 0x7f7f7f7f; asm volatile("" : "+v"(sc8));
    unsigned ao[2][2], an[2][2];
#define PG8_TABDMA(u, slot) do { if (rowtab != nullptr && wid == 0) glds16_s((const void*)(u).rows, (unsigned)mk_lane() * 16u, (unsigned)__builtin_amdgcn_readfirstlane((int)(unsigned)(size_t)(rowtab + (slot) * 256))); } while (0)
    cur.tab = rowtab; nxt.tab = rowtab;
    if (rowtab != nullptr) { PG8_TABDMA(cur, 0); PG8_WAIT_V(0); PG8_BAR; }
    PG8_AOFF(ao, cur);
    const char* cA = cur.a; const char* cB = cur.b;
    PG8_STAGE(PG8_SB(0, 0), cB, voffB); PG8_STAGE(PG8_SB(0, 1), cB + hstep, voffB); PG8_STAGE(PG8_SA(0, 0), cA, ao[0]); PG8_STAGE(PG8_SA(0, 1), cA + PG8_AH(1), ao[1]);
    if (wr == 1) PG8_BAR;
    PG8_WAIT_V(2); PG8_BAR;
    PG8_STAGE(PG8_SB(1, 0), cB + kstep, voffB); PG8_STAGE(PG8_SA(1, 0), cA + kstep, ao[0]); PG8_STAGE(PG8_SB(1, 1), cB + hstep + kstep, voffB);
    PG8_WAIT_V(6); PG8_BAR;
    for (;;) {
        const bool has_next = S.next(ui + 1, nxt);
        if (rowtab != nullptr) nxt.tab = rowtab + ((ui + 1) % 3) * 256;
        if (has_next) PG8_TABDMA(nxt, (ui + 1) % 3);
#pragma unroll
        for (int h = 0; h < 2; ++h)
#pragma unroll
            for (int i = 0; i < 2; ++i) an[h][i] = ao[h][i];
        const char* nA = has_next ? nxt.a : cA; const char* nB = has_next ? nxt.b : cB;
#pragma unroll 1
        for (int t = 0; t < nt; t += 2) {
            const bool last = (t == nt - 2);
            const char* a1 = cA + (size_t)(t + 1) * kstep;
            const char* a2 = last ? nA : cA + (size_t)(t + 2) * kstep; const char* b2 = last ? nB : cB + (size_t)(t + 2) * kstep;
            const char* a3 = a2 + kstep; const char* b3 = b2 + kstep;
            if (last) E.prefetch(pre, cur, wr, wc, fr, fq);
            if (GATHER && last && has_next) PG8_AOFF(an, nxt);
            unsigned o2[2][2];
#pragma unroll
            for (int h = 0; h < 2; ++h)
#pragma unroll
                for (int i = 0; i < 2; ++i) o2[h][i] = (GATHER && last) ? an[h][i] : ao[h][i];
            PG8_LDB(B0, 0, 0); PG8_LDB(B1, 0, 1); PG8_SCHED; PG8_LDA(At, 0, 0); PG8_STAGE(PG8_SA(1, 1), a1 + PG8_AH(1), ao[1]);
            PG8_WAIT_V(8); PG8_WAIT_L(0); PG8_BAR; PG8_MMA(0, 0, At, B0); PG8_MMA(0, 1, At, B1); PG8_BAR; PG8_SCHED;
            PG8_LDA(At, 0, 1); PG8_STAGE(PG8_SB(0, 0), b2, voffB); PG8_STAGE(PG8_SB(0, 1), b2 + hstep, voffB); PG8_STAGE(PG8_SA(0, 0), a2, o2[0]);
            PG8_WAIT_V(8); PG8_WAIT_L(0); PG8_BAR; if (!FP8 || cur.nvalid > HALF) { PG8_MMA(1, 0, At, B0); PG8_MMA(1, 1, At, B1); } PG8_BAR; PG8_SCHED;
            PG8_LDB(B0, 1, 0); PG8_LDB(B1, 1, 1); PG8_SCHED; PG8_LDA(At, 1, 0); PG8_STAGE(PG8_SA(0, 1), a2 + PG8_AH(1), o2[1]);
            PG8_WAIT_V(8); PG8_WAIT_L(0); PG8_BAR; PG8_MMA(0, 0, At, B0); PG8_MMA(0, 1, At, B1); PG8_BAR; PG8_SCHED;
            PG8_LDA(At, 1, 1); PG8_STAGE(PG8_SB(1, 0), b3, voffB); PG8_STAGE(PG8_SB(1, 1), b3 + hstep, voffB); PG8_STAGE(PG8_SA(1, 0), a3, o2[0]);
            PG8_WAIT_V(8); PG8_WAIT_L(0); PG8_BAR; if (!FP8 || cur.nvalid > HALF) { PG8_MMA(1, 0, At, B0); PG8_MMA(1, 1, At, B1); } PG8_BAR; PG8_SCHED;
        }
        if (ALIGN) { if (wr == 0) PG8_BAR; }
        if (FP8) asm volatile("s_nop 15\n\ts_nop 15" ::: "memory");
        E(acc, cur, wr, wc, fr, fq, pre);
        if (!has_next) break;
#pragma unroll
        for (int a = 0; a < 2; ++a)
#pragma unroll
            for (int b = 0; b < 2; ++b)
#pragma unroll
                for (int m = 0; m < 4; ++m)
#pragma unroll
                    for (int n = 0; n < 2; ++n) acc[a][b][m][n] = (f32x4){0.f, 0.f, 0.f, 0.f};
        cur = nxt; cA = nA; cB = nB; ++ui;
#pragma unroll
        for (int h = 0; h < 2; ++h)
#pragma unroll
            for (int i = 0; i < 2; ++i) ao[h][i] = an[h][i];
        if (ALIGN) { if (wr == 1) PG8_BAR; }
    }
    PG8_WAIT_V(0);
    if (!ALIGN) { if (wr == 0) PG8_BAR; }
    PG8_BAR;
#undef PG8_SA
#undef PG8_SB
#undef PG8_STAGE
#undef PG8_LDA
#undef PG8_LDB
#undef PG8_MMA
#undef PG8_WAIT_V
#undef PG8_WAIT_L
#undef PG8_BAR
#undef PG8_SCHED
#undef PG8_AOFF
#undef PG8_TABDMA
#undef PG8_AH
}

struct DenseOrder {
    const char* A; const char* Bt; int K, nM, nN, nwg, G, c, g;
    __device__ __forceinline__ void init(const bf16* A_, const bf16* Bt_, int M, int N, int K_, int G_, int c_, int g_) { A = (const char*)A_; Bt = (const char*)Bt_; K = K_; nM = M / BM; nN = N / BM; nwg = nM * nN; G = G_; c = c_; g = g_; }
    __device__ __forceinline__ bool next(int i, GU& u) const {
        const long L = (long)i * G + c; if (L >= nwg) return false;
        int wgid = (int)L; { const int q = nwg / 8, r = nwg % 8, xcd = wgid % 8, off = wgid / 8; wgid = (xcd < r ? xcd * (q + 1) : r * (q + 1) + (xcd - r) * q) + off; }
        const int nig = 8 * nN, gid = wgid / nig, fm = gid * 8, gsz = (nM - fm) < 8 ? (nM - fm) : 8;
        const int pml = fm + ((wgid % nig) % gsz); u.pm = pml < GLAT / BM ? g * (GLAT / BM) + pml : NLAT / BM + g * (GCTX / BM) + (pml - GLAT / BM);
        u.pn = (wgid % nig) / gsz; u.e = 0; u.nvalid = 256; u.rows = nullptr; u.tab = nullptr;
        u.a = A + (size_t)u.pm * BM * K * 2; u.b = Bt + (size_t)u.pn * BM * K * 2; return true;
    }
};
struct GroupOrder {
    const LAS int* tb; const LAS int* cn; const char* A; const char* Bt; const int* list; size_t bstride; int K, NT, G, c; bool gather;
    __device__ __forceinline__ bool next(int i, GU& u) const {
        const int T = __builtin_amdgcn_readfirstlane(tb[32]), per = G >> 3, x = c / per, j = c - x * per, tlo = (T * x) >> 3, thi = (T * (x + 1)) >> 3, q = i * per + j;
        if (q >= (thi - tlo) * NT) return false;
        int lane_ = mk_lane(); asm volatile("" : "+v"(lane_)); const int tile = tlo + q / NT, pn = q % NT, lane = lane_;
        const unsigned long long bal = __ballot(lane < 32 && tb[(lane & 31) + 1] <= tile);
        const int e = __builtin_amdgcn_readfirstlane(__builtin_popcountll(bal)), mt = tile - __builtin_amdgcn_readfirstlane(tb[e]);
        u.e = e; u.pm = mt; u.pn = pn; const int left = __builtin_amdgcn_readfirstlane(cn[e]) - mt * 256; u.nvalid = left < 256 ? left : 256; u.rows = list + (size_t)e * GCAP + mt * 256;
        u.b = Bt + (size_t)e * bstride + (size_t)pn * BM * K * 2;
        u.a = gather ? A : A + (size_t)tile * BM * K * 2;
        return true;
    }
};

template <bool F8, int PN0> struct EpiPT {
    static constexpr bool PERM = true; static constexpr float sc = F8 ? 1.f / 64.f : 1.f; bf16* P; const float* qg; long kdelta;
    __device__ __forceinline__ void qk_unit(const f32x4 (&acc)[2][2][4][2], const GU& u, int wr, int wc, int fr, int fq) const {
        const int row0 = u.pm * BM + wr * 64 + fr, cw = wc * 32 + 8 * fq, isq = (u.pn + PN0) == 2, odd = fq & 1;
        const bool lat = u.pm * BM < NLAT;
        const float* gp = qg + (isq ? 0L : kdelta) + (wc & 1) * 32 + 8 * fq;
        const f32x4 g0 = *(const f32x4*)gp, g1 = *(const f32x4*)(gp + 4);
        const float qs = isq ? 0.17677669529f * 1.44269504089f : 1.f;
#pragma unroll
        for (int ai = 0; ai < 2; ++ai)
#pragma unroll
            for (int m = 0; m < 4; ++m) {
                const int tok = row0 + ai * HALF + m * 16, s = tok & 2047; const float pos = (float)(fq < 2 ? (s >> 6) : (s & 63));
                float cs[8], sn[8];
#pragma unroll
                for (int j = 0; j < 8; ++j) { const float invj = j == 0 ? 1.f : j == 1 ? 0.316227766f : j == 2 ? 0.1f : j == 3 ? 0.0316227766f : j == 4 ? 0.01f : j == 5 ? 0.00316227766f : j == 6 ? 0.001f : 0.000316227766f; float rr = pos * invj * 0.15915494309f; rr -= rintf(rr); cs[j] = lat ? __builtin_amdgcn_cosf(rr) : 1.f; sn[j] = lat ? __builtin_amdgcn_sinf(rr) : 0.f; }
#pragma unroll
                for (int bj = 0; bj < 2; ++bj) {
                    float x[8]; float ss = 0.f;
#pragma unroll
                    for (int n = 0; n < 2; ++n)
#pragma unroll
                        for (int q = 0; q < 4; ++q) { x[4 * n + q] = acc[ai][bj][m][n][q] * sc; ss += x[4 * n + q] * x[4 * n + q]; }
                    ss += __shfl_xor(ss, 16); ss += __shfl_xor(ss, 32);
                    const float rstd = rsqrtf(ss * (1.f / 32.f) + EPS);
                    float o[8];
#pragma unroll
                    for (int j = 0; j < 8; ++j) { const float y = x[j] * rstd * (j < 4 ? g0[j & 3] : g1[j & 3]), p = __shfl_xor(y, 16); o[j] = (odd ? (p * sn[j] + y * cs[j]) : (y * cs[j] - p * sn[j])) * qs; }
                    u32x4 w; w.x = cvt_pk_bf16(o[0], o[1]); w.y = cvt_pk_bf16(o[2], o[3]); w.z = cvt_pk_bf16(o[4], o[5]); w.w = cvt_pk_bf16(o[6], o[7]);
                    *(u32x4*)(P + (size_t)tok * DINP + (u.pn + PN0) * BM + bj * HALF + cw) = w;
                }
            }
    }
    struct Pre {};
    __device__ __forceinline__ void prefetch(Pre&, const GU&, int, int, int, int) const {}
    __device__ __forceinline__ void operator()(const f32x4 (&acc)[2][2][4][2], const GU& u, int wr, int wc, int fr, int fq, const Pre&) const {
        if ((u.pn + PN0) == 2 || (u.pn + PN0) == 3) { qk_unit(acc, u, wr, wc, fr, fq); return; }
        const int row0 = u.pm * BM + wr * 64 + fr, cw = wc * 32 + 8 * fq;
        const int kind = ((u.pn + PN0) == 5 || (u.pn + PN0) == 6) ? 1 : (((u.pn + PN0) >= 8) ? 2 : 0);
        const int cbase = kind == 0 ? ((u.pn + PN0) < 5 ? (u.pn + PN0) * BM : 1536) : (kind == 1 ? 1280 + ((u.pn + PN0) - 5) * HALF : 1792 + ((u.pn + PN0) - 8) * HALF);
#pragma unroll
        for (int ai = 0; ai < 2; ++ai)
#pragma unroll
            for (int m = 0; m < 4; ++m) { bf16* rowp = P + (size_t)(row0 + ai * HALF + m * 16) * DINP + cbase + cw;
                if (kind == 0) {
#pragma unroll
                    for (int bj = 0; bj < 2; ++bj) { const f32x4 v0 = acc[ai][bj][m][0] * sc, v1 = acc[ai][bj][m][1] * sc;
                        u32x4 w; w.x = cvt_pk_bf16(v0[0], v0[1]); w.y = cvt_pk_bf16(v0[2], v0[3]); w.z = cvt_pk_bf16(v1[0], v1[1]); w.w = cvt_pk_bf16(v1[2], v1[3]);
                        *(u32x4*)(rowp + bj * HALF) = w; }
                } else {
                    float o[8];
#pragma unroll
                    for (int n = 0; n < 2; ++n)
#pragma unroll
                        for (int q = 0; q < 4; ++q) { const float a = acc[ai][0][m][n][q] * sc, g = acc[ai][1][m][n][q] * sc;
                            o[4 * n + q] = kind == 1 ? a * __builtin_amdgcn_rcpf(1.f + __builtin_amdgcn_exp2f(-1.44269504089f * g)) : a * g; }
                    u32x4 w; w.x = cvt_pk_bf16(o[0], o[1]); w.y = cvt_pk_bf16(o[2], o[3]); w.z = cvt_pk_bf16(o[4], o[5]); w.w = cvt_pk_bf16(o[6], o[7]);
                    *(u32x4*)rowp = w;
                }
            }
    }
};
typedef EpiPT<(G1_FP8 != 0), 0> EpiP;
template <bool F8> struct EpiXT {
    static constexpr bool PERM = true; bf16* X; const void* R0; const void* R1; const float* g1; float* SS; int rf32;
    struct Pre { f32x4 gv[2][2]; };
    __device__ __forceinline__ void prefetch(Pre& p, const GU& u, int wr, int wc, int fr, int fq) const {
        const float* g = g1 + (size_t)tok_modrow(u.pm * BM) * MODW + u.pn * BM + wc * 32 + 8 * fq;
#pragma unroll
        for (int bj = 0; bj < 2; ++bj)
#pragma unroll
            for (int n = 0; n < 2; ++n) p.gv[bj][n] = *(const f32x4*)(g + bj * HALF + 4 * n) * (F8 ? 1.f / 64.f : 1.f);
    }
    __device__ __forceinline__ void operator()(const f32x4 (&acc)[2][2][4][2], const GU& u, int wr, int wc, int fr, int fq, const Pre& pre) const {
        const int row0 = u.pm * BM + wr * 64 + fr, col0 = u.pn * BM + wc * 32 + 8 * fq;
        const bool lat = u.pm * BM < NLAT; const size_t roff = (size_t)(lat ? row0 : row0 - NLAT) * D + col0;
        const f32x4 (&gv)[2][2] = pre.gv;
#pragma unroll
        for (int ai = 0; ai < 2; ++ai) {
            f32x4 rv[4][2][2];
            if (rf32) { const float* R = (const float*)(lat ? R0 : R1) + roff;
#pragma unroll
                for (int m = 0; m < 4; ++m)
#pragma unroll
                    for (int bj = 0; bj < 2; ++bj)
#pragma unroll
                        for (int n = 0; n < 2; ++n) rv[m][bj][n] = *(const f32x4*)(R + (size_t)(ai * HALF + m * 16) * D + bj * HALF + 4 * n);
            } else { const bf16* R = (const bf16*)(lat ? R0 : R1) + roff; u32x4 rw[4][2];
#pragma unroll
                for (int m = 0; m < 4; ++m)
#pragma unroll
                    for (int bj = 0; bj < 2; ++bj) rw[m][bj] = *(const u32x4*)(R + (size_t)(ai * HALF + m * 16) * D + bj * HALF);
#pragma unroll
                for (int m = 0; m < 4; ++m)
#pragma unroll
                    for (int bj = 0; bj < 2; ++bj) { const u32x4 w = rw[m][bj]; rv[m][bj][0] = (f32x4){blo(w.x), bhi(w.x), blo(w.y), bhi(w.y)}; rv[m][bj][1] = (f32x4){blo(w.z), bhi(w.z), blo(w.w), bhi(w.w)}; }
            }
#pragma unroll
            for (int m = 0; m < 4; ++m) { bf16* rowp = X + (size_t)(row0 + ai * HALF + m * 16) * D + col0; float ssq = 0.f;
#pragma unroll
                for (int bj = 0; bj < 2; ++bj) { const f32x4 v0 = rv[m][bj][0] + gv[bj][0] * acc[ai][bj][m][0], v1 = rv[m][bj][1] + gv[bj][1] * acc[ai][bj][m][1];
                    ssq += (v0[0] * v0[0] + v0[1] * v0[1]) + (v0[2] * v0[2] + v0[3] * v0[3]) + (v1[0] * v1[0] + v1[1] * v1[1]) + (v1[2] * v1[2] + v1[3] * v1[3]);
                    u32x4 w; w.x = cvt_pk_bf16(v0[0], v0[1]); w.y = cvt_pk_bf16(v0[2], v0[3]); w.z = cvt_pk_bf16(v1[0], v1[1]); w.w = cvt_pk_bf16(v1[2], v1[3]);
                    *(u32x4*)(rowp + bj * HALF) = w; }
                ssq += __shfl_xor(ssq, 16); ssq += __shfl_xor(ssq, 32);
                if (fq == 0) SS[(size_t)(row0 + ai * HALF + m * 16) * 16 + 4 * u.pn + wc] = ssq; }
        }
    }
};
constexpr float W8_SCALE = 64.f, HID_SCALE = 4.f, O8_SCALE = 8.f;
typedef EpiXT<false> EpiX;
struct EpiHid {
    static constexpr bool PERM = true; bf16* HID; const float* bgu; const LAS int* tb;
    struct Pre { f32x4 bgl[2], bup[2]; };
    __device__ __forceinline__ void prefetch(Pre& p, const GU& u, int wr, int wc, int fr, int fq) const {
        const float* bg = bgu + (size_t)u.e * 2 * FF + u.pn * HALF + wc * 32 + 8 * fq;
#pragma unroll
        for (int n = 0; n < 2; ++n) { p.bgl[n] = *(const f32x4*)(bg + 4 * n); p.bup[n] = *(const f32x4*)(bg + FF + 4 * n); }
    }
    __device__ __forceinline__ void operator()(const f32x4 (&acc)[2][2][4][2], const GU& u, int wr, int wc, int fr, int fq, const Pre& pre) const {
        const int row0 = (__builtin_amdgcn_readfirstlane(tb[u.e]) + u.pm) * BM + wr * 64 + fr, j0 = u.pn * HALF + wc * 32 + 8 * fq;
        const f32x4 (&bgl)[2] = pre.bgl; const f32x4 (&bup)[2] = pre.bup;
        const int odd = fq & 1;
#pragma unroll
        for (int ai = 0; ai < 2; ++ai)
#pragma unroll
            for (int mp = 0; mp < 2; ++mp) {
                u32x2 w[2];
#pragma unroll
                for (int t = 0; t < 2; ++t) { const int m = 2 * mp + t; float hv[8];
#pragma unroll
                    for (int n = 0; n < 2; ++n)
#pragma unroll
                        for (int q = 0; q < 4; q += 2) {
                            typedef float f2 __attribute__((ext_vector_type(2)));
                            f2 gl = (f2){acc[ai][0][m][n][q], acc[ai][0][m][n][q + 1]} * (1.f / W8_SCALE) + (f2){bgl[n][q], bgl[n][q + 1]};
                            f2 up = (f2){acc[ai][1][m][n][q], acc[ai][1][m][n][q + 1]} * (1.f / W8_SCALE) + (f2){bup[n][q], bup[n][q + 1]};
                            gl.x = fminf(gl.x, 7.f); gl.y = fminf(gl.y, 7.f); up.x = fminf(fmaxf(up.x, -7.f), 7.f); up.y = fminf(fmaxf(up.y, -7.f), 7.f);
                            const f2 ar = gl * (-1.702f * 1.44269504089f); f2 dn; dn.x = __builtin_amdgcn_exp2f(ar.x); dn.y = __builtin_amdgcn_exp2f(ar.y); dn = dn + 1.f;
                            f2 rc; rc.x = __builtin_amdgcn_rcpf(dn.x); rc.y = __builtin_amdgcn_rcpf(dn.y);
                            const f2 hh = (up * HID_SCALE + HID_SCALE) * gl * rc; hv[4 * n + q] = hh.x; hv[4 * n + q + 1] = hh.y; }
                    w[t].x = (unsigned)__builtin_amdgcn_cvt_pk_fp8_f32(hv[0], hv[1], 0, false); w[t].x = (unsigned)__builtin_amdgcn_cvt_pk_fp8_f32(hv[2], hv[3], (int)w[t].x, true);
                    w[t].y = (unsigned)__builtin_amdgcn_cvt_pk_fp8_f32(hv[4], hv[5], 0, false); w[t].y = (unsigned)__builtin_amdgcn_cvt_pk_fp8_f32(hv[6], hv[7], (int)w[t].y, true); }
                const u32x2 send = odd ? w[0] : w[1], keep = odd ? w[1] : w[0];
                u32x2 recv; recv.x = (unsigned)__shfl_xor((int)send.x, 16); recv.y = (unsigned)__shfl_xor((int)send.y, 16);
                const u32x4 o = odd ? (u32x4){recv.x, recv.y, keep.x, keep.y} : (u32x4){keep.x, keep.y, recv.x, recv.y};
                *(u32x4*)((unsigned char*)HID + (size_t)(row0 + ai * HALF + (2 * mp + odd) * 16) * FF + (j0 - 8 * odd)) = o; }
    }
};
struct EpiO {
    static constexpr bool PERM = true; unsigned char* O8; const float* bdn;
    struct Pre { f32x4 bv[2][2]; };
    __device__ __forceinline__ void prefetch(Pre& p, const GU& u, int wr, int wc, int fr, int fq) const {
        const float* bp = bdn + (size_t)u.e * D + u.pn * BM + wc * 32 + 8 * fq;
#pragma unroll
        for (int bj = 0; bj < 2; ++bj)
#pragma unroll
            for (int n = 0; n < 2; ++n) p.bv[bj][n] = *(const f32x4*)(bp + bj * HALF + 4 * n);
    }
    __device__ __forceinline__ void operator()(const f32x4 (&acc)[2][2][4][2], const GU& u, int wr, int wc, int fr, int fq, const Pre& pre) const {
        const int r0 = wr * 64 + fr, col0 = u.pn * BM + wc * 32 + 8 * fq, odd = fq & 1;
        f32x4 bv[2][2];
#pragma unroll
        for (int bj = 0; bj < 2; ++bj)
#pragma unroll
            for (int n = 0; n < 2; ++n) bv[bj][n] = pre.bv[bj][n] * O8_SCALE;
        constexpr float sc = O8_SCALE / (W8_SCALE * HID_SCALE);
#pragma unroll
        for (int ai = 0; ai < 2; ++ai)
#pragma unroll
            for (int mp = 0; mp < 2; ++mp) {
                const int r = r0 + ai * HALF + (2 * mp + odd) * 16;
                const bool ok = r < u.nvalid; const int slot = ok ? u.tab[r] : 0;
                unsigned char* rowp = O8 + (size_t)slot * D + (col0 - 8 * odd);
#pragma unroll
                for (int bj = 0; bj < 2; ++bj) {
                    u32x2 w[2];
#pragma unroll
                    for (int q = 0; q < 2; ++q) { const f32x4 v0 = acc[ai][bj][2 * mp + q][0] * sc + bv[bj][0], v1 = acc[ai][bj][2 * mp + q][1] * sc + bv[bj][1];
                        w[q].x = (unsigned)__builtin_amdgcn_cvt_pk_fp8_f32(v0[0], v0[1], 0, false); w[q].x = (unsigned)__builtin_amdgcn_cvt_pk_fp8_f32(v0[2], v0[3], (int)w[q].x, true);
                        w[q].y = (unsigned)__builtin_amdgcn_cvt_pk_fp8_f32(v1[0], v1[1], 0, false); w[q].y = (unsigned)__builtin_amdgcn_cvt_pk_fp8_f32(v1[2], v1[3], (int)w[q].y, true); }
                    const u32x2 send = odd ? w[0] : w[1], keep = odd ? w[1] : w[0];
                    u32x2 recv; recv.x = (unsigned)__shfl_xor((int)send.x, 16); recv.y = (unsigned)__shfl_xor((int)send.y, 16);
                    const u32x4 o = odd ? (u32x4){recv.x, recv.y, keep.x, keep.y} : (u32x4){keep.x, keep.y, recv.x, recv.y};
                    if (ok) *(u32x4*)(rowp + bj * HALF) = o;
                }
            }
    }
};
}


#define XB_TMO      128
#define XB_XCNT(j)  (256  + 64 * (j))
#define XB_XSUB(j)  (1280 + 64 * (j))
#define XB_XGEN(j)  (2304 + 64 * (j))
#define XB_TOP      3328
#define XB_TOPGEN   3392
#define XCD_BAR_WORDS 3456
#define XB_SPIN_CAP (1u << 18)

__device__ __forceinline__ unsigned xb_ld(unsigned* p)              { return __hip_atomic_load(p, __ATOMIC_RELAXED, __HIP_MEMORY_SCOPE_AGENT); }
__device__ __forceinline__ unsigned xb_add(unsigned* p, unsigned v) { return __hip_atomic_fetch_add(p, v, __ATOMIC_RELAXED, __HIP_MEMORY_SCOPE_AGENT); }
__device__ __forceinline__ unsigned xb_xcc_id() { return (unsigned)__builtin_amdgcn_s_getreg((3 << 11) | 20) & 0xFu; }
#define XB_SPIN(cond, bar) do { unsigned _sp = 0; while (cond) { __builtin_amdgcn_s_sleep(1); \
    if ((++_sp & 255u) == 0u) { if (xb_ld(&(bar)[XB_TMO])) break; if (_sp > XB_SPIN_CAP) { atomicAdd(&(bar)[XB_TMO], 1u); break; } } } } while (0)

struct XcdBarrier {
    unsigned* bar; unsigned x; unsigned gsize; unsigned w;
    volatile LAS unsigned* st;
};

__device__ __forceinline__ XcdBarrier xcd_barrier_post(unsigned* bar, volatile LAS unsigned* st, unsigned gsize, unsigned w) {
    XcdBarrier b; b.bar = bar; b.x = xb_xcc_id(); b.st = st; b.gsize = gsize; b.w = w;
    if (b.w == 0u && mk_lane() == 0) (void)xb_add(&bar[XB_XCNT(b.x)], 1u);
    return b;
}
__device__ __forceinline__ void xcd_barrier_complete(unsigned* bar, unsigned x, unsigned& nloc, unsigned& nx, unsigned G) {
    unsigned sum, cnt, mine, sp = 0u;
    for (;;) {
        sum = 0u; cnt = 0u; mine = 0u;
#pragma unroll
        for (unsigned j = 0; j < 16; ++j) { const unsigned c = xb_ld(&bar[XB_XCNT(j)]); sum += c; cnt += (c > 0u) ? 1u : 0u; mine = (j == x) ? c : mine; }
        if (sum == G) break;
        __builtin_amdgcn_s_sleep(1);
        if ((++sp & 255u) == 0u) { if (xb_ld(&bar[XB_TMO])) break; if (sp > XB_SPIN_CAP) { atomicAdd(&bar[XB_TMO], 1u); break; } }
    }
    nloc = mine > 0u ? mine : 1u; nx = cnt > 0u ? cnt : 1u;
}

__device__ __forceinline__ void xcd_barrier(const XcdBarrier& b) {
    asm volatile("s_waitcnt vmcnt(0)" ::: "memory");
    __syncthreads();
    if (b.w == 0u && mk_lane() == 0) {
        unsigned* bar = b.bar;
        __builtin_amdgcn_s_waitcnt(0);
        unsigned nloc = b.st[0], nx = b.st[1];
        if (nloc == 0u) { xcd_barrier_complete(bar, b.x, nloc, nx, b.gsize); b.st[0] = nloc; b.st[1] = nx; }
        const unsigned old = xb_add(&bar[XB_XSUB(b.x)], 1u);
        const unsigned gen = old / nloc;
        if (old + 1u == (gen + 1u) * nloc) {
            __builtin_amdgcn_fence(__ATOMIC_RELEASE, "agent");
            asm volatile("s_waitcnt vmcnt(0)" ::: "memory");
            const unsigned og = xb_add(&bar[XB_TOP], 1u);
            const unsigned tg = og / nx;
            if (og + 1u == (tg + 1u) * nx) xb_add(&bar[XB_TOPGEN], 1u);
            else XB_SPIN(xb_ld(&bar[XB_TOPGEN]) == tg, bar);
            __builtin_amdgcn_fence(__ATOMIC_ACQUIRE, "agent");
            xb_add(&bar[XB_XGEN(b.x)], 1u);
            asm volatile("s_waitcnt vmcnt(0)" ::: "memory");
        } else {
            XB_SPIN(xb_ld(&bar[XB_XGEN(b.x)]) == gen, bar);
            __builtin_amdgcn_fence(__ATOMIC_ACQUIRE, "agent");
            asm volatile("s_waitcnt vmcnt(0)" ::: "memory");
        }
    }
    __syncthreads();
}

constexpr int LDS_STAGE = 131072, LDS_MISC = 135168, LDS_BYTES = 147456;
struct Args { const float* in[31]; float* out; unsigned char* ws; int ph_lo, ph_hi; };

template <int MAP> __device__ __forceinline__ int map_col(int n) {
    if (MAP == 0) return n;
    const int up = n >= FF ? 1 : 0, j = n - up * FF; return (j >> 7) * 256 + up * 128 + (j & 127);
}
__device__ __forceinline__ int map_win(int n) { const int g = n >> 8, c = n & 255;
    if (g == 5 || g == 6) return (5 + (c >> 7)) * 256 + (g - 5) * 128 + (c & 127);
    if (g == 8 || g == 9) return (8 + (c >> 7)) * 256 + (g - 8) * 128 + (c & 127);
    return n; }
struct TItem { const float* W; bf16* WT; int K, N, k0, n0, r0, f8; };
__device__ __forceinline__ bool t_decode(long it, int part, const float* w_in, const float* w_out, const float* w_gu, const float* w_dn, bf16* WIN, bf16* WOUT, bf16* WGU, bf16* WDN, unsigned char* WINQ, TItem& t) {
    constexpr int NB_IN = (G1_QLO == 0) ? (DIN - G1_QHI * 256) / 32 : DIN / 32;
    constexpr int I_IN = (D / 128) * NB_IN, I_OUT = (D / 128) * (D / 32), I_GU = (D / 128) * (2 * FF / 32), I_DN = (FF / 128) * (D / 32);
    constexpr long T_IN = (long)NL * I_IN, T_OUT = (long)NL * I_OUT, T_GU = (long)NL * NE * I_GU, T_DN = (long)NL * NE * I_DN;
    if (part == 0) return false;
    if (part == 3) { if (it >= T_IN + T_OUT) {
            constexpr int I_INQ = (D / 128) * (DINQ / 32); it -= T_IN + T_OUT;
            if (it >= (long)NL * I_INQ) {
                it -= (long)NL * I_INQ; if (!G2_FP8_L1 || it >= I_OUT) return false;
                const int i = (int)it, nblk = D / 32, kb = i / nblk, nb = i % nblk;
                t.W = w_out + (size_t)(NL - 1) * D * D; t.WT = (bf16*)(WINQ + (WS_WOUTQ - WS_WINQ)); t.K = D; t.N = D; t.f8 = 1; t.k0 = 128 * kb; t.n0 = 32 * nb; t.r0 = t.n0;
                return true; }
            const int m = (int)(it / I_INQ), i = (int)(it % I_INQ), nblk = DINQ / 32, kb = i / nblk, nb = i % nblk;
            t.W = w_in + (size_t)m * D * DIN; t.WT = (bf16*)(WINQ + (size_t)m * DINQ * D); t.K = D; t.N = DIN; t.f8 = 1; t.k0 = 128 * kb; t.n0 = G1_QLO * 256 + 32 * nb; t.r0 = map_win(t.n0) - G1_QLO * 256;
            return true; } }
    else { const int l = part - 1; if (it >= (long)NE * (I_GU + I_DN)) return false; it = it < (long)NE * I_GU ? T_IN + T_OUT + (long)l * NE * I_GU + it : T_IN + T_OUT + T_GU + (long)l * NE * I_DN + (it - (long)NE * I_GU); }
    if (it >= T_IN + T_OUT + T_GU + T_DN) return false;
    int m, i, map = 0;
    if (it < T_IN) { m = (int)(it / I_IN); i = (int)(it % I_IN); t.W = w_in + (size_t)m * D * DIN; t.WT = G1_FP8 ? (bf16*)((unsigned char*)WIN + (size_t)m * DIN * D) : WIN + (size_t)m * DIN * D; t.K = D; t.N = DIN; t.f8 = G1_FP8; map = 2; }
    else if (it < T_IN + T_OUT) { it -= T_IN; m = (int)(it / I_OUT); i = (int)(it % I_OUT); t.W = w_out + (size_t)m * D * D; t.WT = WOUT + (size_t)m * D * D; t.K = D; t.N = D; t.f8 = 0; }
    else if (it < T_IN + T_OUT + T_GU) { it -= T_IN + T_OUT; m = (int)(it / I_GU); i = (int)(it % I_GU); t.W = w_gu + (size_t)m * D * 2 * FF; t.WT = (bf16*)((unsigned char*)WGU + (size_t)m * 2 * FF * D); t.K = D; t.N = 2 * FF; map = 1; t.f8 = 1; }
    else { it -= T_IN + T_OUT + T_GU; m = (int)(it / I_DN); i = (int)(it % I_DN); t.W = w_dn + (size_t)m * FF * D; t.WT = (bf16*)((unsigned char*)WDN + (size_t)m * D * FF); t.K = FF; t.N = D; t.f8 = 1; }
    const int nblk = map == 2 ? NB_IN : t.N / 32, kb = i / nblk, nb = i % nblk; t.k0 = 128 * kb; t.n0 = (map == 2 ? DIN - NB_IN * 32 : 0) + 32 * nb; t.r0 = map == 1 ? map_col<1>(t.n0) : (map == 2 ? map_win(t.n0) : t.n0);
    return true;
}
__device__ __forceinline__ void t_load(const TItem& t, int lane, f32x4 (&v)[16]) {
#pragma unroll
    for (int i = 0; i < 16; ++i) { const int kk = 8 * i + (lane >> 3); v[i] = __builtin_nontemporal_load((const f32x4*)(t.W + (size_t)(t.k0 + kk) * t.N + t.n0 + 4 * (lane & 7))); }
}
__device__ __forceinline__ void t_store(const TItem& t, int lane, const f32x4 (&v)[16], LAS float* scr) {
#pragma unroll
    for (int i = 0; i < 16; ++i) { const int kk = 8 * i + (lane >> 3); LAS float* p = scr + kk * 33 + 4 * (lane & 7); p[0] = v[i].x; p[1] = v[i].y; p[2] = v[i].z; p[3] = v[i].w; }
    LDS_WAIT();
    const int n = lane >> 1, hh = lane & 1; const LAS float* s = scr + (64 * hh) * 33 + n;
    if (t.f8) {
        unsigned w[16];
#pragma unroll
        for (int q = 0; q < 16; ++q) { int x = __builtin_amdgcn_cvt_pk_fp8_f32(s[(4 * q) * 33] * pg8::W8_SCALE, s[(4 * q + 1) * 33] * pg8::W8_SCALE, 0, false);
            x = __builtin_amdgcn_cvt_pk_fp8_f32(s[(4 * q + 2) * 33] * pg8::W8_SCALE, s[(4 * q + 3) * 33] * pg8::W8_SCALE, x, true); w[q] = (unsigned)x; }
        unsigned char* dst = (unsigned char*)t.WT + (size_t)(t.r0 + n) * t.K + t.k0 + 64 * hh;
#pragma unroll
        for (int q = 0; q < 4; ++q) *(u32x4*)(dst + 16 * q) = (u32x4){w[4 * q], w[4 * q + 1], w[4 * q + 2], w[4 * q + 3]};
    } else {
        bf16* dst = t.WT + (size_t)(t.r0 + n) * t.K + t.k0 + 64 * hh;
#pragma unroll
        for (int q = 0; q < 8; ++q) { u32x4 o; o.x = pk2(s[(8 * q) * 33], s[(8 * q + 1) * 33]); o.y = pk2(s[(8 * q + 2) * 33], s[(8 * q + 3) * 33]); o.z = pk2(s[(8 * q + 4) * 33], s[(8 * q + 5) * 33]); o.w = pk2(s[(8 * q + 6) * 33], s[(8 * q + 7) * 33]);
            *(u32x4*)(dst + 8 * q) = o; }
    }
    LDS_WAIT();
}
__device__ __forceinline__ void ph_prologue(LAS unsigned char* lds, const Args& a, const Grp grp, int part, long it_lo = 0, long it_hi = (1L << 40)) {
    int tid_ = MK_TID(grp); asm volatile("" : "+v"(tid_)); const int tid = tid_, wave = tid >> 6, lane = tid & 63, G = grp.n, vcu = grp.v;
    const float* c = a.in[1]; const float* c_ctx = a.in[3]; const float* w_mod = a.in[4]; const float* b_mod = a.in[5];
    float* mod = (float*)(a.ws + WS_MOD);
    if (part == 0) { LAS float* sc = (LAS float*)lds; LAS float* part_ = sc + 17 * D;
      for (int it = vcu; it < NL * (MODW / 64); it += G) {
        const int l = it / (MODW / 64), cb = it % (MODW / 64), col = tid & 63, w = tid >> 6;
        __syncthreads();
        for (int idx = tid; idx < 17 * D; idx += 512) { const int r = idx >> 10, k = idx & 1023; sc[idx] = silu_f(r < 16 ? c[r * D + k] : c_ctx[k]); }
        __syncthreads();
        float acc[17];
#pragma unroll
        for (int r = 0; r < 17; ++r) acc[r] = 0.f;
        const float* wp = w_mod + ((size_t)l * D + 128 * w) * MODW + cb * 64 + col;
#pragma unroll 4
        for (int kk = 0; kk < 128; kk += 4) {
            const float w0 = wp[(size_t)kk * MODW], w1 = wp[(size_t)(kk + 1) * MODW], w2 = wp[(size_t)(kk + 2) * MODW], w3 = wp[(size_t)(kk + 3) * MODW];
#pragma unroll
            for (int r = 0; r < 17; ++r) { const f32x4 s = *(const LAS f32x4*)(sc + r * D + 128 * w + kk); acc[r] += s.x * w0 + s.y * w1 + s.z * w2 + s.w * w3; }
        }
#pragma unroll
        for (int r = 0; r < 17; ++r) part_[(w * 17 + r) * 64 + col] = acc[r];
        __syncthreads();
        for (int idx = tid; idx < 17 * 64; idx += 512) { const int r = idx >> 6, cc = idx & 63; float s = 0.f;
#pragma unroll
            for (int ww = 0; ww < 8; ++ww) s += part_[(ww * 17 + r) * 64 + cc];
            mod[((size_t)l * 17 + r) * MODW + cb * 64 + cc] = s + b_mod[l * MODW + cb * 64 + cc]; }
      }
      __syncthreads(); }
    if (part == 0) { unsigned char* rwt = a.ws + WS_RWT;
      for (int idx = vcu * 512 + tid; idx < NL * D * NE; idx += G * 512) { const int l = idx / (D * NE), r = idx % (D * NE), k = r >> 5, e = r & 31; const float w = a.in[25][idx];
          const bf16 hi = f2bf(w), lo = f2bf(w - bf2f(hi)); bf16* dst = (bf16*)(rwt + (size_t)l * (2 * 32 * 2064) + (size_t)e * 2064) + k; dst[0] = hi; *(bf16*)((unsigned char*)dst + 32 * 2064) = lo; } }
    __syncthreads();
    LAS float* scr = (LAS float*)(lds + wave * 16896);
    bf16* WIN = (bf16*)(a.ws + WS_WIN); bf16* WOUT = (bf16*)(a.ws + WS_WOUT); bf16* WGU = (bf16*)(a.ws + WS_WGU); bf16* WDN = (bf16*)(a.ws + WS_WDN);
    const long gw = (long)vcu * 8 + wave, ngw = (long)G * 8;
    TItem cur, nxt; f32x4 vc[16], vn[16];
    long it = it_lo + gw; bool have = it < it_hi && t_decode(it, part, a.in[8], a.in[24], a.in[27], a.in[29], WIN, WOUT, WGU, WDN, a.ws + WS_WINQ, cur);
    if (have) t_load(cur, lane, vc);
    while (have) {
        it += ngw; const bool hn = it < it_hi && t_decode(it, part, a.in[8], a.in[24], a.in[27], a.in[29], WIN, WOUT, WGU, WDN, a.ws + WS_WINQ, nxt);
        if (hn) t_load(nxt, lane, vn);
        t_store(cur, lane, vc, scr);
        cur = nxt; have = hn;
#pragma unroll
        for (int i = 0; i < 16; ++i) vc[i] = vn[i];
    }
}

struct RowIn { u32x4 ow[4]; u32x4 xw[2]; f32x4 gt; };
struct Coef { f32x4 a[4], b[4], g2[4]; };
__device__ __forceinline__ void row_load(RowIn& r, bool from_input, const float* src_f32, const bf16* X, const unsigned char* O8, const float* gate, int tok, int lane) {
    if (from_input) {
#pragma unroll
        for (int q = 0; q < 4; ++q) r.ow[q] = *(const u32x4*)(src_f32 + 16 * lane + 4 * q);
    } else {
        r.xw[0] = *(const u32x4*)(X + (size_t)tok * D + 16 * lane); r.xw[1] = *(const u32x4*)(X + (size_t)tok * D + 16 * lane + 8);
#pragma unroll
        for (int k = 0; k < 4; ++k) r.ow[k] = *(const u32x4*)(O8 + (size_t)(tok * 4 + k) * D + 16 * lane);
        r.gt = *(const f32x4*)(gate + (size_t)tok * 4);
    }
}
__device__ __forceinline__ void coef_load(Coef& c, int l, int mr, int lane, const float* mod, const float* norm_g, bool with_norm) {
    if (with_norm) { const float* mrow = mod + ((size_t)l * 17 + mr) * MODW + 16 * lane;
#pragma unroll
        for (int q = 0; q < 4; ++q) { const f32x4 g = *(const f32x4*)(norm_g + 16 * lane + 4 * q), sh = *(const f32x4*)(mrow + 4 * q), sc = *(const f32x4*)(mrow + D + 4 * q); c.a[q] = g * (1.f + sc); c.b[q] = sh; } }
    if (l > 0) {
#pragma unroll
        for (int q = 0; q < 4; ++q) c.g2[q] = *(const f32x4*)(mod + ((size_t)(l - 1) * 17 + mr) * MODW + 5 * D + 16 * lane + 4 * q); }
}
__device__ __forceinline__ void combine16(const RowIn& r, const Coef& c, float (&v)[16]) {
    float s[16];
#pragma unroll
    for (int i = 0; i < 16; ++i) s[i] = 0.f;
#pragma unroll
    for (int k = 0; k < 4; ++k) { const float gk = r.gt[k] * (1.f / pg8::O8_SCALE);
#pragma unroll
        for (int q = 0; q < 4; ++q) { const f32x2 lo = __builtin_amdgcn_cvt_pk_f32_fp8((int)r.ow[k][q], false), hi = __builtin_amdgcn_cvt_pk_f32_fp8((int)r.ow[k][q], true);
            s[4 * q] += gk * lo.x; s[4 * q + 1] += gk * lo.y; s[4 * q + 2] += gk * hi.x; s[4 * q + 3] += gk * hi.y; } }
#pragma unroll
    for (int q = 0; q < 4; ++q) { const f32x4 g2 = c.g2[q]; const unsigned w0 = r.xw[q >> 1][(q & 1) * 2], w1 = r.xw[q >> 1][(q & 1) * 2 + 1];
        v[4 * q] = blo(w0) + g2.x * s[4 * q]; v[4 * q + 1] = bhi(w0) + g2.y * s[4 * q + 1]; v[4 * q + 2] = blo(w1) + g2.z * s[4 * q + 2]; v[4 * q + 3] = bhi(w1) + g2.w * s[4 * q + 3]; }
}
__device__ __forceinline__ void norm1_row(const RowIn& r, const Coef& c, int l, int tok, int lane, bf16* Xd, bf16* H, unsigned char* HQ) {
    float v[16];
    if (l == 0) {
#pragma unroll
        for (int q = 0; q < 4; ++q) { v[4 * q] = __uint_as_float(r.ow[q].x); v[4 * q + 1] = __uint_as_float(r.ow[q].y); v[4 * q + 2] = __uint_as_float(r.ow[q].z); v[4 * q + 3] = __uint_as_float(r.ow[q].w); }
    } else {
        combine16(r, c, v);
        u32x4 o0, o1; o0.x = pk2(v[0], v[1]); o0.y = pk2(v[2], v[3]); o0.z = pk2(v[4], v[5]); o0.w = pk2(v[6], v[7]); o1.x = pk2(v[8], v[9]); o1.y = pk2(v[10], v[11]); o1.z = pk2(v[12], v[13]); o1.w = pk2(v[14], v[15]);
        *(u32x4*)(Xd + (size_t)tok * D + 16 * lane) = o0; *(u32x4*)(Xd + (size_t)tok * D + 16 * lane + 8) = o1;
    }
    float ss = 0.f;
#pragma unroll
    for (int i = 0; i < 16; ++i) ss += v[i] * v[i];
    const float rstd = rsqrtf(wave_sum(ss) * (1.f / D) + EPS);
    unsigned hw[8];
#pragma unroll
    for (int q = 0; q < 4; ++q) { const f32x4 ca = c.a[q], cb = c.b[q];
        hw[2 * q] = pk2(v[4 * q] * rstd * ca.x + cb.x, v[4 * q + 1] * rstd * ca.y + cb.y); hw[2 * q + 1] = pk2(v[4 * q + 2] * rstd * ca.z + cb.z, v[4 * q + 3] * rstd * ca.w + cb.w); }
    *(u32x4*)(H + (size_t)tok * D + 16 * lane) = (u32x4){hw[0], hw[1], hw[2], hw[3]}; *(u32x4*)(H + (size_t)tok * D + 16 * lane + 8) = (u32x4){hw[4], hw[5], hw[6], hw[7]};
    if (DINQ > 0) { u32x4 w8;
#pragma unroll
        for (int q = 0; q < 4; ++q) { int t8 = __builtin_amdgcn_cvt_pk_fp8_f32(blo(hw[2 * q]), bhi(hw[2 * q]), 0, false); t8 = __builtin_amdgcn_cvt_pk_fp8_f32(blo(hw[2 * q + 1]), bhi(hw[2 * q + 1]), t8, true); w8[q] = (unsigned)t8; }
        *(u32x4*)(HQ + (size_t)tok * D + 16 * lane) = w8; }
}
__device__ __forceinline__ void ph_norm1(int l, const Args& a, const Grp grp) {
    int tid_ = MK_TID(grp); asm volatile("" : "+v"(tid_)); const int tid = tid_, lane = tid & 63, gw = grp.v * 8 + __builtin_amdgcn_readfirstlane(tid >> 6), ngw = grp.n * 8;
    const float* xin = a.in[0]; const float* ctxin = a.in[2]; const float* norm_g = a.in[6] + l * D;
    const bf16* X = (const bf16*)(a.ws + WS_X); bf16* Xd = (bf16*)(a.ws + WS_X); const unsigned char* O8 = a.ws + WS_O; const float* gate = (const float*)(a.ws + WS_GATE); const float* mod = (const float*)(a.ws + WS_MOD); bf16* H = (bf16*)(a.ws + WS_H); unsigned char* HQ = a.ws + WS_HQ;
    const int rpw = (GTOK + ngw - 1) / ngw, t0 = gw * rpw, t1 = (t0 + rpw < GTOK) ? t0 + rpw : GTOK;
    if (t0 >= t1) return;
    Coef c; int cmr = -1;
    RowIn ra, rb, rc;
#define N1_LOAD(r, t) do { const int _tk = gtok(grp.g, (t) < t1 ? (t) : t1 - 1); row_load(r, l == 0, _tk < NLAT ? xin + (size_t)_tk * D : ctxin + (size_t)(_tk - NLAT) * D, X, O8, gate, _tk, lane); } while (0)
#define N1_ROW(r, t) do { if ((t) < t1) { const int _tk = gtok(grp.g, (t)), _mr = tok_modrow(_tk); if (_mr != cmr) { cmr = _mr; coef_load(c, l, _mr, lane, mod, norm_g, true); } norm1_row(r, c, l, _tk, lane, Xd, H, HQ); } } while (0)
    N1_LOAD(ra, t0); N1_LOAD(rb, t0 + 1);
    for (int t = t0; t < t1; t += 3) {
        N1_LOAD(rc, t + 2); N1_ROW(ra, t);
        N1_LOAD(ra, t + 3); N1_ROW(rb, t + 1);
        N1_LOAD(rb, t + 4); N1_ROW(rc, t + 2);
    }
#undef N1_LOAD
#undef N1_ROW
}
__device__ __forceinline__ void ph_final(const Args& a, const Grp grp) {
    int tid_ = MK_TID(grp); asm volatile("" : "+v"(tid_)); const int tid = tid_, lane = tid & 63, gw = grp.v * 8 + __builtin_amdgcn_readfirstlane(tid >> 6), ngw = grp.n * 8;
    const bf16* X = (const bf16*)(a.ws + WS_X); const unsigned char* O8 = a.ws + WS_O; const float* gate = (const float*)(a.ws + WS_GATE); const float* mod = (const float*)(a.ws + WS_MOD);
    const int rpw = (GLAT + ngw - 1) / ngw, t0 = gw * rpw, t1 = (t0 + rpw < GLAT) ? t0 + rpw : GLAT;
    if (t0 >= t1) return;
    Coef c; int cmr = -1;
    RowIn ra, rb, rc;
#define FN_LOAD(r, t) row_load(r, false, nullptr, X, O8, gate, grp.g * GLAT + ((t) < t1 ? (t) : t1 - 1), lane)
#define FN_ROW(r, t) do { if ((t) < t1) { const int _tk = grp.g * GLAT + (t), _mr = tok_modrow(_tk); if (_mr != cmr) { cmr = _mr; coef_load(c, NL, _mr, lane, mod, nullptr, false); } float v[16]; combine16(r, c, v); \
        _Pragma("unroll") for (int q = 0; q < 4; ++q) *(f32x4*)(a.out + (size_t)_tk * D + 16 * lane + 4 * q) = (f32x4){v[4 * q], v[4 * q + 1], v[4 * q + 2], v[4 * q + 3]}; } } while (0)
    FN_LOAD(ra, t0); FN_LOAD(rb, t0 + 1);
    for (int t = t0; t < t1; t += 3) {
        FN_LOAD(rc, t + 2); FN_ROW(ra, t);
        FN_LOAD(ra, t + 3); FN_ROW(rb, t + 1);
        FN_LOAD(rb, t + 4); FN_ROW(rc, t + 2);
    }
#undef FN_LOAD
#undef FN_ROW
}

__device__ __forceinline__ void ph_prep(int l, const Args& a, const Grp grp) {
    int tid_ = MK_TID(grp); asm volatile("" : "+v"(tid_)); const int tid = tid_, lane = tid & 63, G = grp.n, vcu = grp.v;
    bf16* P = (bf16*)(a.ws + WS_P); bf16* VT = (bf16*)(a.ws + WS_VT);
    const float* qg = a.in[12]; const float* kg = a.in[13];
    const int gw = vcu * 8 + (tid >> 6), ngw = G * 8;
    for (int it = gw; it < (GTOK / 64) * 4; it += ngw) {
        const int h = it & 3, tok0 = gtok(grp.g, (it >> 2) * 64), tok = tok0 + lane;
        int b, key0; if (tok < NLAT) { b = tok >> 11; key0 = tok0 & 2047; } else { b = (tok - NLAT) >> 8; key0 = 2048 + ((tok0 - NLAT) & 255); }
        const int g = lane >> 5, k32 = lane & 31, pos = g * 32 + ((k32 & 15) >> 2) * 8 + (k32 >> 4) * 4 + (k32 & 3);
        const bf16* vp = P + (size_t)tok * DINP + 1024 + h * 64;
        bf16* dst = VT + ((size_t)(b * 4 + h) * 64) * NKEY + key0 + pos;
#pragma unroll
        for (int q = 0; q < 8; ++q) { const u32x4 w = *(const u32x4*)(vp + 8 * q);
            dst[(size_t)(8 * q + 0) * NKEY] = (bf16)(w.x & 0xffffu); dst[(size_t)(8 * q + 1) * NKEY] = (bf16)(w.x >> 16); dst[(size_t)(8 * q + 2) * NKEY] = (bf16)(w.y & 0xffffu); dst[(size_t)(8 * q + 3) * NKEY] = (bf16)(w.y >> 16);
            dst[(size_t)(8 * q + 4) * NKEY] = (bf16)(w.z & 0xffffu); dst[(size_t)(8 * q + 5) * NKEY] = (bf16)(w.z >> 16); dst[(size_t)(8 * q + 6) * NKEY] = (bf16)(w.w & 0xffffu); dst[(size_t)(8 * q + 7) * NKEY] = (bf16)(w.w >> 16); }
    }
}
__device__ __forceinline__ void ph_mix_a(LAS unsigned char* lds, int l, int ntok, const Args& a, const Grp grp) {
    int tid_ = MK_TID(grp); asm volatile("" : "+v"(tid_)); const int tid = tid_, wave = __builtin_amdgcn_readfirstlane(tid >> 6), lane = tid & 63, fr = lane & 15, fq = lane >> 4, G = grp.n, vcu = grp.v;
    const bf16* P = (const bf16*)(a.ws + WS_P); bf16* Y = (bf16*)(a.ws + WS_Y); unsigned char* Y8 = a.ws + WS_Y8; const bool y8 = G2_FP8_L1 && l == NL - 1;
    const float* vg = a.in[9] + l * 256; const float* aws = a.in[10] + (size_t)l * 4 * 128 * 128; const float* abs_ = a.in[11] + l * 4 * 128;
    constexpr int VPITCH = 272;
    const int nit = (ntok / 128) * 4;
    const int q = tid >> 2, part = tid & 3, p = wave * 16 + fr;
    int hcur = -1; float vgr[16]; bf16x8_t wf[4]; float bs = 0.f;
    u32x4 w0, w1, n0, n1;
#define MA_LOADV(x0, x1, it) do { const bf16* _vp = P + (size_t)(gtok(grp.g, ((it) >> 2) * 128) + q) * DINP + 256 + ((it) & 3) * 64 + part * 16; x0 = *(const u32x4*)_vp; x1 = *(const u32x4*)(_vp + 8); } while (0)
    if (vcu < nit) MA_LOADV(w0, w1, vcu);
    for (int it = vcu; it < nit; it += G) {
        const int h = it & 3, tokbase = gtok(grp.g, (it >> 2) * 128), tok = tokbase + p;
        u32x2 uw[4];
#pragma unroll
        for (int cb = 0; cb < 4; ++cb) uw[cb] = *(const u32x2*)(P + (size_t)tok * DINP + h * 64 + 16 * cb + 4 * fq);
        if (h != hcur) { hcur = h;
#pragma unroll
            for (int i = 0; i < 16; ++i) vgr[i] = vg[h * 64 + part * 16 + i];
            const float* wrow = aws + ((size_t)h * 128 + p) * 128;
#pragma unroll
            for (int ks = 0; ks < 4; ++ks) { const f32x4 wa = *(const f32x4*)(wrow + 32 * ks + 8 * fq), wb = *(const f32x4*)(wrow + 32 * ks + 8 * fq + 4);
                u32x4 wp; wp.x = pk2(wa.x, wa.y); wp.y = pk2(wa.z, wa.w); wp.z = pk2(wb.x, wb.y); wp.w = pk2(wb.z, wb.w); wf[ks] = __builtin_bit_cast(bf16x8_t, wp); }
            bs = abs_[h * 128 + p]; }
        __syncthreads();
        {
            float v[16] = {blo(w0.x), bhi(w0.x), blo(w0.y), bhi(w0.y), blo(w0.z), bhi(w0.z), blo(w0.w), bhi(w0.w), blo(w1.x), bhi(w1.x), blo(w1.y), bhi(w1.y), blo(w1.z), bhi(w1.z), blo(w1.w), bhi(w1.w)};
            float ss = 0.f;
#pragma unroll
            for (int i = 0; i < 16; ++i) { v[i] = gelu_tanh(v[i]); ss += v[i] * v[i]; }
            ss += __shfl_xor(ss, 1); ss += __shfl_xor(ss, 2);
            const float rstd = rsqrtf(ss * (1.f / 64.f) + EPS);
#pragma unroll
            for (int i = 0; i < 16; ++i) { const int c = part * 16 + i; *(LAS bf16*)(lds + c * VPITCH + q * 2) = f2bf(v[i] * rstd * vgr[i]); }
        }
        __syncthreads();
        if (it + G < nit) MA_LOADV(n0, n1, it + G);
        {
            f32x4 acc[4];
#pragma unroll
            for (int cb = 0; cb < 4; ++cb) acc[cb] = (f32x4){0.f, 0.f, 0.f, 0.f};
#pragma unroll
            for (int ks = 0; ks < 4; ++ks) {
#pragma unroll
                for (int cb = 0; cb < 4; ++cb) {
                    const bf16x8_t vf = *(const LAS bf16x8_t*)(lds + (16 * cb + fr) * VPITCH + (32 * ks + 8 * fq) * 2);
                    acc[cb] = __builtin_amdgcn_mfma_f32_16x16x32_bf16(vf, wf[ks], acc[cb], 0, 0, 0);
                }
            }
#pragma unroll
            for (int cb = 0; cb < 4; ++cb) {
                const int c = h * 64 + 16 * cb + 4 * fq;
                const float y0 = gelu_tanh(blo(uw[cb].x)) * (acc[cb][0] + bs), y1 = gelu_tanh(bhi(uw[cb].x)) * (acc[cb][1] + bs), y2 = gelu_tanh(blo(uw[cb].y)) * (acc[cb][2] + bs), y3 = gelu_tanh(bhi(uw[cb].y)) * (acc[cb][3] + bs);
                if (y8) { int t8 = __builtin_amdgcn_cvt_pk_fp8_f32(y0, y1, 0, false); t8 = __builtin_amdgcn_cvt_pk_fp8_f32(y2, y3, t8, true); *(unsigned*)(Y8 + (size_t)tok * D + c) = (unsigned)t8; }
                else { u32x2 o; o.x = pk2(y0, y1); o.y = pk2(y2, y3); *(u32x2*)(Y + (size_t)tok * D + c) = o; }
            }
        }
        w0 = n0; w1 = n1;
    }
#undef MA_LOADV
    __syncthreads();
}

__device__ __forceinline__ void ph_mix_c(LAS unsigned char* lds, int l, int ntok, const Args& a, const Grp grp) {
    int tid_ = MK_TID(grp); asm volatile("" : "+v"(tid_)); const int tid = tid_, wave = __builtin_amdgcn_readfirstlane(tid >> 6), lane = tid & 63, G = grp.n, vcu = grp.v;
    const bf16* P = (const bf16*)(a.ws + WS_P); bf16* Y = (bf16*)(a.ws + WS_Y); unsigned char* Y8 = a.ws + WS_Y8; const bool y8 = G2_FP8_L1 && l == NL - 1;
    const float* cw = a.in[19] + l * 31 * 256; const float* cb = a.in[20] + l * 256; const float* lg = a.in[21] + l * 256; const float* lb = a.in[22] + l * 256;
    LAS float* zs = (LAS float*)lds;
    LAS float* wl = (LAS float*)(lds + 96256);
    __syncthreads();
    for (int i = tid; i < 31 * 256; i += 512) wl[i] = cw[i];
    float gv[4], bv[4], cbv[4];
#pragma unroll
    for (int hp = 0; hp < 2; ++hp)
#pragma unroll
        for (int e = 0; e < 2; ++e) { const int c = hp * 128 + 2 * lane + e; gv[2 * hp + e] = lg[c]; bv[2 * hp + e] = lb[c]; cbv[2 * hp + e] = cb[c]; }
    const int nit = ntok / 64;
    u32x4 zr[6];
#define MC_LOADZ(item) do { const int _tok0 = gtok(grp.g, (item) * 64); int _s0, _len; if (_tok0 < NLAT) { _s0 = _tok0 & ~2047; _len = 2048; } else { _s0 = NLAT + ((_tok0 - NLAT) & ~255); _len = 256; } \
        _Pragma("unroll") for (int k = 0; k < 6; ++k) { const int idx = tid + 512 * k, r = idx >> 5, c8 = (idx & 31) * 8, pos = _tok0 - _s0 - 15 + r; zr[k] = (u32x4){0u, 0u, 0u, 0u}; \
            if (idx < 94 * 32 && pos >= 0 && pos < _len) zr[k] = *(const u32x4*)(P + (size_t)(_s0 + pos) * DINP + 1280 + c8); } } while (0)
    for (int item = G - 1 - vcu; item < nit; item += G) {
        const int tok0 = gtok(grp.g, item * 64);
        MC_LOADZ(item);
        __syncthreads();
#pragma unroll
        for (int k = 0; k < 6; ++k) { const int idx = tid + 512 * k, r = idx >> 5, c8 = (idx & 31) * 8;
            if (idx < 94 * 32) { const u32x4 zz = zr[k];
                *(LAS f32x4*)(zs + r * 256 + c8) = (f32x4){blo(zz.x), bhi(zz.x), blo(zz.y), bhi(zz.y)}; *(LAS f32x4*)(zs + r * 256 + c8 + 4) = (f32x4){blo(zz.z), bhi(zz.z), blo(zz.w), bhi(zz.w)}; } }
        __syncthreads();
        float res[8][4];
#pragma unroll
        for (int hp = 0; hp < 2; ++hp) {
            const int c = hp * 128 + 2 * lane;
            float w0[31], w1[31];
#pragma unroll
            for (int j = 0; j < 31; ++j) { const f32x2 w = *(const LAS f32x2*)(wl + j * 256 + c); w0[j] = w.x; w1[j] = w.y; }
            float a0[8], a1[8];
#pragma unroll
            for (int r = 0; r < 8; ++r) { a0[r] = cbv[2 * hp]; a1[r] = cbv[2 * hp + 1]; }
#pragma unroll
            for (int rr = 0; rr < 38; ++rr) {
                const f32x2 z = *(const LAS f32x2*)(zs + (8 * wave + rr) * 256 + c);
#pragma unroll
                for (int r = 0; r < 8; ++r) { const int j = rr - r; if (j >= 0 && j < 31) { a0[r] += z.x * w0[j]; a1[r] += z.y * w1[j]; } }
            }
#pragma unroll
            for (int r = 0; r < 8; ++r) { res[r][2 * hp] = a0[r]; res[r][2 * hp + 1] = a1[r]; }
        }
#pragma unroll
        for (int r = 0; r < 8; ++r) {
            const float mean = wave_sum(res[r][0] + res[r][1] + res[r][2] + res[r][3]) * (1.f / 256.f);
            const float d0 = res[r][0] - mean, d1 = res[r][1] - mean, d2 = res[r][2] - mean, d3 = res[r][3] - mean;
            const float rstd = rsqrtf(wave_sum(d0 * d0 + d1 * d1 + d2 * d2 + d3 * d3) * (1.f / 256.f) + EPS);
            const int tok = tok0 + 8 * wave + r;
            const float y0 = silu_f(d0 * rstd * gv[0] + bv[0]), y1 = silu_f(d1 * rstd * gv[1] + bv[1]), y2 = silu_f(d2 * rstd * gv[2] + bv[2]), y3 = silu_f(d3 * rstd * gv[3] + bv[3]);
            *(unsigned short*)(Y8 + (size_t)tok * D + 512 + 2 * lane) = (unsigned short)__builtin_amdgcn_cvt_pk_fp8_f32(y0, y1, 0, false); *(unsigned short*)(Y8 + (size_t)tok * D + 512 + 128 + 2 * lane) = (unsigned short)__builtin_amdgcn_cvt_pk_fp8_f32(y2, y3, 0, false);
            *(unsigned*)(Y + (size_t)tok * D + 512 + 2 * lane) = pk2(y0, y1); *(unsigned*)(Y + (size_t)tok * D + 512 + 128 + 2 * lane) = pk2(y2, y3);
        }
    }
#undef MC_LOADZ
    __syncthreads();
}

__device__ __forceinline__ void ph_mix_d(int l, int ntok, const Args& a, const Grp grp) {
    const bf16* P = (const bf16*)(a.ws + WS_P); bf16* Y = (bf16*)(a.ws + WS_Y); unsigned char* Y8 = a.ws + WS_Y8; const bool y8 = G2_FP8_L1 && l == NL - 1;     const float* dw = a.in[23] + l * 3 * 256;
    int tid_ = MK_TID(grp); asm volatile("" : "+v"(tid_));
    const int c8 = (tid_ & 31) * 8, rid = grp.v * 16 + (tid_ >> 5), nruns = grp.n * 16;
    constexpr int CH = 9;
    const int R = (ntok + nruns - 1) / nruns, t0 = rid * R, t1 = (t0 + R < ntok) ? t0 + R : ntok;
    f32x4 wa[3], wb[3];
#pragma unroll
    for (int j = 0; j < 3; ++j) { wa[j] = *(const f32x4*)(dw + j * 256 + c8); wb[j] = *(const f32x4*)(dw + j * 256 + c8 + 4); }
    for (int tc = t0; tc < t1; tc += CH) {
        u32x4 dd[CH + 2], db[CH];
#pragma unroll
        for (int i = 0; i < CH + 2; ++i) { int t = tc - 1 + i; t = t < 0 ? 0 : (t >= ntok ? ntok - 1 : t); dd[i] = *(const u32x4*)(P + (size_t)gtok(grp.g, t) * DINP + 1792 + c8); }
#pragma unroll
        for (int i = 0; i < CH; ++i) { int t = tc + i; t = t >= ntok ? ntok - 1 : t; db[i] = *(const u32x4*)(P + (size_t)gtok(grp.g, t) * DINP + 1536 + c8); }
#pragma unroll
        for (int i = 0; i < CH; ++i) {
            const int t = tc + i;
            if (t < t1) {
                const int tok = gtok(grp.g, t);
                int s0, len; if (tok < NLAT) { s0 = tok & ~2047; len = 2048; } else { s0 = NLAT + ((tok - NLAT) & ~255); len = 256; }
                const int pos = tok - s0;
                float acc[8];
#pragma unroll
                for (int k = 0; k < 8; ++k) acc[k] = 0.f;
#pragma unroll
                for (int j = 0; j < 3; ++j) { const int pp = pos + j - 1;
                    if (pp >= 0 && pp < len) { const u32x4 d = dd[i + j];
                        acc[0] += blo(d.x) * wa[j].x; acc[1] += bhi(d.x) * wa[j].y; acc[2] += blo(d.y) * wa[j].z; acc[3] += bhi(d.y) * wa[j].w;
                        acc[4] += blo(d.z) * wb[j].x; acc[5] += bhi(d.z) * wb[j].y; acc[6] += blo(d.w) * wb[j].z; acc[7] += bhi(d.w) * wb[j].w; } }
                const u32x4 b = db[i];
                if (y8) { u32x2 o8; int t8 = __builtin_amdgcn_cvt_pk_fp8_f32(blo(b.x) * acc[0], bhi(b.x) * acc[1], 0, false); t8 = __builtin_amdgcn_cvt_pk_fp8_f32(blo(b.y) * acc[2], bhi(b.y) * acc[3], t8, true); o8.x = (unsigned)t8;
                    t8 = __builtin_amdgcn_cvt_pk_fp8_f32(blo(b.z) * acc[4], bhi(b.z) * acc[5], 0, false); t8 = __builtin_amdgcn_cvt_pk_fp8_f32(blo(b.w) * acc[6], bhi(b.w) * acc[7], t8, true); o8.y = (unsigned)t8;
                    *(u32x2*)(Y8 + (size_t)tok * D + 768 + c8) = o8; }
                else { u32x4 o; o.x = pk2(blo(b.x) * acc[0], bhi(b.x) * acc[1]); o.y = pk2(blo(b.y) * acc[2], bhi(b.y) * acc[3]); o.z = pk2(blo(b.z) * acc[4], bhi(b.z) * acc[5]); o.w = pk2(blo(b.w) * acc[6], bhi(b.w) * acc[7]);
                    *(u32x4*)(Y + (size_t)tok * D + 768 + c8) = o; }
            }
        }
    }
}

__device__ __forceinline__ void ph_attn(LAS unsigned char* lds, int l, const Args& a, const Grp grp) {
    int tid_ = MK_TID(grp); asm volatile("" : "+v"(tid_)); const int tid = tid_, wid = __builtin_amdgcn_readfirstlane(tid >> 6), lane = tid & 63, fr = lane & 15, fq = lane >> 4, G = grp.n, vcu = grp.v;
    const bf16* P = (const bf16*)(a.ws + WS_P); bf16* Y = (bf16*)(a.ws + WS_Y); unsigned char* Y8 = a.ws + WS_Y8; const bool y8 = G2_FP8_L1 && l == NL - 1;
    const float* subln = a.in[18] + l * 64;
    const float lam_init = lam_init_of(l);
    float lam, negM[2];
    { const float d1 = lane < 32 ? a.in[14][l * 32 + lane] * a.in[15][l * 32 + lane] : 0.f, d2 = lane < 32 ? a.in[16][l * 32 + lane] * a.in[17][l * 32 + lane] : 0.f;
      lam = __expf(wave_sum(d1)) - __expf(wave_sum(d2)) + lam_init;
#pragma unroll
      for (int m = 0; m < 2; ++m) { const float mq = wave_max(lane < 32 ? fabsf(a.in[12][l * 64 + m * 32 + lane]) : 0.f), mk = wave_max(lane < 32 ? fabsf(a.in[13][l * 64 + m * 32 + lane]) : 0.f); negM[m] = -8.2433f * mq * mk; } }
    const int nunits = (l == 0) ? 256 + 32 : 256;
    const int prow = (wid * 64 + lane) >> 3, pch = (lane & 7) ^ (prow & 7);
    const int rdsw = fr & 7;
    const int vch = (lane & 7) ^ (2 * ((prow >> 1) & 3));
    const int vq = fr >> 2, vp = fr & 3, vsw = 2 * (2 * (fq & 1) + (vq >> 1));
    const int vrd0 = (4 * fq + vq) * 128 + 8 * (vp & 1);
    if (wid >= 4) __builtin_amdgcn_s_setprio(1);
    for (int u = vcu; u < nunits; u += G) {
        int b, h, qtok0, t0, nt;
        if (u < 256) { b = grp.g * 8 + (u >> 5); h = (u >> 3) & 3; qtok0 = b * 2048 + (u & 7) * 256; t0 = 0; nt = 36; }
        else { const int uc = u - 256; b = grp.g * 8 + (uc >> 2); h = uc & 3; qtok0 = NLAT + b * 256; t0 = 32; nt = 4; }
        bf16x8_t Qf[2][2];
#pragma unroll
        for (int m = 0; m < 2; ++m)
#pragma unroll
            for (int qb = 0; qb < 2; ++qb) Qf[m][qb] = *(const bf16x8_t*)(P + (size_t)(qtok0 + wid * 32 + qb * 16 + fr) * DINP + 512 + h * 64 + m * 32 + 8 * fq);
        f32x4 O[2][4][2], Ls[2][2];
        const bf16x8_t ones = __builtin_bit_cast(bf16x8_t, (u32x4){0x3f803f80u, 0x3f803f80u, 0x3f803f80u, 0x3f803f80u});
#pragma unroll
        for (int m = 0; m < 2; ++m)
#pragma unroll
            for (int qb = 0; qb < 2; ++qb) { Ls[m][qb] = (f32x4){0.f, 0.f, 0.f, 0.f};
#pragma unroll
                for (int eb = 0; eb < 4; ++eb) O[m][eb][qb] = (f32x4){0.f, 0.f, 0.f, 0.f}; }
#define ATT_ISSUE(j) do { const int _t = t0 + (j); const int _kt = _t < 32 ? b * 2048 + _t * 64 : NLAT + b * 256 + (_t - 32) * 64; const int _s = (j) % 3; \
        __builtin_amdgcn_global_load_lds((const unsigned*)(P + (size_t)(_kt + prow) * DINP + 768 + h * 64 + pch * 8), (LAS unsigned*)(lds + _s * 16384 + wid * 1024), 16, 0, 0); \
        __builtin_amdgcn_global_load_lds((const unsigned*)(P + (size_t)(_kt + prow) * DINP + 1024 + h * 64 + vch * 8), (LAS unsigned*)(lds + _s * 16384 + 8192 + wid * 1024), 16, 0, 0); } while (0)
        asm volatile("s_waitcnt lgkmcnt(0)\n\ts_barrier" ::: "memory");
        ATT_ISSUE(0); ATT_ISSUE(1);
        for (int i = 0; i < nt; ++i) {
            if (i + 1 < nt) asm volatile("s_waitcnt vmcnt(2)\n\ts_barrier" ::: "memory"); else asm volatile("s_waitcnt vmcnt(0)\n\ts_barrier" ::: "memory");
            if (i + 2 < nt) ATT_ISSUE(i + 2);
            const LAS unsigned char* Ks = lds + (i % 3) * 16384; const LAS unsigned char* Vs = Ks + 8192;
            bf16x8_t Pf[2][2][2];
#pragma unroll
            for (int m = 0; m < 2; ++m) {
                f32x4 S[4][2];
#pragma unroll
                for (int kb = 0; kb < 4; ++kb) {
                    const bf16x8_t kf = *(const LAS bf16x8_t*)(Ks + (16 * kb + fr) * 128 + (((m * 4 + fq) ^ rdsw) * 16));
#pragma unroll
                    for (int qb = 0; qb < 2; ++qb) S[kb][qb] = __builtin_amdgcn_mfma_f32_16x16x32_bf16(kf, Qf[m][qb], (f32x4){negM[m], negM[m], negM[m], negM[m]}, 0, 0, 0);
                }
#pragma unroll
                for (int qb = 0; qb < 2; ++qb) {
#pragma unroll
                    for (int kb = 0; kb < 4; ++kb) {
#pragma unroll
                        for (int j = 0; j < 4; ++j) S[kb][qb][j] = __builtin_amdgcn_exp2f(S[kb][qb][j]); }
#pragma unroll
                    for (int g = 0; g < 2; ++g) { u32x4 w; w.x = pg8::cvt_pk_bf16(S[2 * g][qb][0], S[2 * g][qb][1]); w.y = pg8::cvt_pk_bf16(S[2 * g][qb][2], S[2 * g][qb][3]);
                        w.z = pg8::cvt_pk_bf16(S[2 * g + 1][qb][0], S[2 * g + 1][qb][1]); w.w = pg8::cvt_pk_bf16(S[2 * g + 1][qb][2], S[2 * g + 1][qb][3]); Pf[m][g][qb] = __builtin_bit_cast(bf16x8_t, w);
                        Ls[m][qb] = __builtin_amdgcn_mfma_f32_16x16x32_bf16(ones, Pf[m][g][qb], Ls[m][qb], 0, 0, 0); }
                }
            }
#pragma unroll
            for (int eb = 0; eb < 4; ++eb)
#pragma unroll
                for (int g = 0; g < 2; ++g) {
                    const int vslot = ((2 * eb + (vp >> 1)) ^ vsw) * 16;
                    const v4i16_t t0 = __builtin_amdgcn_ds_read_tr16_b64_v4i16((LAS v4i16_t*)(Vs + (32 * g) * 128 + vrd0 + vslot)), t1 = __builtin_amdgcn_ds_read_tr16_b64_v4i16((LAS v4i16_t*)(Vs + (32 * g + 16) * 128 + vrd0 + vslot));
                    const bf16x8_t vf = __builtin_shufflevector(t0, t1, 0, 1, 2, 3, 4, 5, 6, 7);
#pragma unroll
                    for (int m = 0; m < 2; ++m)
#pragma unroll
                        for (int qb = 0; qb < 2; ++qb) O[m][eb][qb] = __builtin_amdgcn_mfma_f32_16x16x32_bf16(vf, Pf[m][g][qb], O[m][eb][qb], 0, 0, 0);
                }
        }
#undef ATT_ISSUE
#pragma unroll
        for (int qb = 0; qb < 2; ++qb) {
            const float l1 = Ls[0][qb][0], l2 = Ls[1][qb][0];
            const float r1 = 1.f / l1, r2 = lam / l2;
            f32x4 o[4]; float ss = 0.f;
#pragma unroll
            for (int eb = 0; eb < 4; ++eb) { o[eb] = O[0][eb][qb] * r1 - O[1][eb][qb] * r2; ss += o[eb][0] * o[eb][0] + o[eb][1] * o[eb][1] + o[eb][2] * o[eb][2] + o[eb][3] * o[eb][3]; }
            ss += __shfl_xor(ss, 16); ss += __shfl_xor(ss, 32);
            const float rs = rsqrtf(ss * (1.f / 64.f) + EPS) * (1.f - lam_init);
            bf16* yp = Y + (size_t)(qtok0 + wid * 32 + qb * 16 + fr) * D + 256 + h * 64 + 4 * fq;
#pragma unroll
            for (int eb = 0; eb < 4; ++eb) { const f32x4 g = *(const f32x4*)(subln + 16 * eb + 4 * fq); const float y0 = o[eb][0] * rs * g.x, y1 = o[eb][1] * rs * g.y, y2 = o[eb][2] * rs * g.z, y3 = o[eb][3] * rs * g.w;
                if (y8) { int t8 = __builtin_amdgcn_cvt_pk_fp8_f32(y0, y1, 0, false); t8 = __builtin_amdgcn_cvt_pk_fp8_f32(y2, y3, t8, true); *(unsigned*)(Y8 + (size_t)(yp - Y) + 16 * eb) = (unsigned)t8; }
                else { u32x2 w; w.x = pk2(y0, y1); w.y = pk2(y2, y3); *(u32x2*)(yp + 16 * eb) = w; } }
        }
    }
    __builtin_amdgcn_s_setprio(0);
    asm volatile("s_waitcnt vmcnt(0) lgkmcnt(0)\n\ts_barrier" ::: "memory");
}

constexpr int RW_PITCH = 2064, RW_PART = NE * RW_PITCH, RW_IMG = 2 * RW_PART;
__device__ __forceinline__ void ph_route(LAS unsigned char* lds, int l, int ntok, const Args& a, const Grp grp) {
    int tid_ = MK_TID(grp); asm volatile("" : "+v"(tid_)); const int tid = tid_, wave = __builtin_amdgcn_readfirstlane(tid >> 6), lane = tid & 63, fr = lane & 15, fq = lane >> 4, G = grp.n, vcu = grp.v;
    const bf16* X = (const bf16*)(a.ws + WS_X); const float* mod = (const float*)(a.ws + WS_MOD); const float* norm_g = a.in[7] + l * D; const float* rb = a.in[26] + l * NE;
    unsigned char* H8 = a.ws + WS_H8; unsigned* cnt = (unsigned*)(a.ws + WS_CTL) + CW_CNT + (grp.g * NL + l) * 64; int* list = (int*)(a.ws + WS_LIST) + (size_t)grp.g * NE * GCAP; float* gate = (float*)(a.ws + WS_GATE);
    const float* SSp = (const float*)(a.ws + WS_SS);
    LAS unsigned* hist = (LAS unsigned*)(lds + LDS_MISC + 4096); LAS unsigned* gbase = hist + NE;
    LAS unsigned short* sel_e = (LAS unsigned short*)(lds + LDS_MISC + 4352); LAS unsigned short* sel_p = sel_e + 1024;
    __syncthreads();
    if (tid < NE) hist[tid] = 0u;
    for (int i = tid; i < 1024; i += 512) sel_e[i] = 0xffffu;
    const int nitems = ntok / 16, ipw = (nitems + G - 1) / G, it0 = vcu * ipw, it1 = (it0 + ipw < nitems) ? it0 + ipw : nitems;
    const int kcol = 128 * wave + 8 * fq;
    bf16x8_t wh[2][4], wl[2][4];
    { const unsigned char* img = a.ws + WS_RWT + (size_t)l * RW_IMG;
#pragma unroll
      for (int nb = 0; nb < 2; ++nb)
#pragma unroll
          for (int ks = 0; ks < 4; ++ks) { const unsigned char* wp = img + (nb * 16 + fr) * RW_PITCH + (kcol + 32 * ks) * 2; wh[nb][ks] = *(const bf16x8_t*)wp; wl[nb][ks] = *(const bf16x8_t*)(wp + RW_PART); } }
    f32x4 ca[4][2], cb[4][2]; int cmr = -1;
    u32x4 xw[4], xn[4]; f32x4 p4, pn4;
#define RT_LOAD(xv, pv, it) do { const int _tok = gtok(grp.g, (it) * 16) + fr; const bf16* _xr = X + (size_t)_tok * D + kcol; \
        _Pragma("unroll") for (int ks = 0; ks < 4; ++ks) xv[ks] = *(const u32x4*)(_xr + 32 * ks); pv = *(const f32x4*)(SSp + (size_t)_tok * 16 + 4 * fq); } while (0)
    if (it0 < it1) RT_LOAD(xw, p4, it0);
    for (int ib = it0; ib < it1; ib += 5) {
        const int ni = (it1 - ib < 5) ? it1 - ib : 5;
        for (int s = 0; s < ni; ++s) {
            const int it = ib + s, tb0 = gtok(grp.g, it * 16), tok = tb0 + fr, mr = tok_modrow(tb0);
            if (it + 1 < it1) RT_LOAD(xn, pn4, it + 1);
            if (mr != cmr) { cmr = mr; const float* mrow = mod + ((size_t)l * 17 + mr) * MODW + kcol; const float* gp = norm_g + kcol;
#pragma unroll
                for (int ks = 0; ks < 4; ++ks)
#pragma unroll
                    for (int hf = 0; hf < 2; ++hf) { const f32x4 g = *(const f32x4*)(gp + 32 * ks + 4 * hf), sh = *(const f32x4*)(mrow + 3 * D + 32 * ks + 4 * hf), sc = *(const f32x4*)(mrow + 4 * D + 32 * ks + 4 * hf);
                        ca[ks][hf] = g * (1.f + sc); cb[ks][hf] = sh; } }
            float ss = (p4.x + p4.y) + (p4.z + p4.w);
            ss += __shfl_xor(ss, 16); ss += __shfl_xor(ss, 32);
            const float rstd = rsqrtf(ss * (1.f / D) + EPS);
            f32x4 acc[2] = {{0.f, 0.f, 0.f, 0.f}, {0.f, 0.f, 0.f, 0.f}};
#pragma unroll
            for (int ks = 0; ks < 4; ++ks) {
                float h[8];
                { const u32x4 w = xw[ks]; const f32x4 x0 = {blo(w.x), bhi(w.x), blo(w.y), bhi(w.y)}, x1 = {blo(w.z), bhi(w.z), blo(w.w), bhi(w.w)};
                  const f32x4 h0 = x0 * rstd * ca[ks][0] + cb[ks][0], h1 = x1 * rstd * ca[ks][1] + cb[ks][1];
                  h[0] = h0.x; h[1] = h0.y; h[2] = h0.z; h[3] = h0.w; h[4] = h1.x; h[5] = h1.y; h[6] = h1.z; h[7] = h1.w; }
                u32x2 w8; { int t = __builtin_amdgcn_cvt_pk_fp8_f32(h[0], h[1], 0, false); t = __builtin_amdgcn_cvt_pk_fp8_f32(h[2], h[3], t, true); w8.x = (unsigned)t;
                            t = __builtin_amdgcn_cvt_pk_fp8_f32(h[4], h[5], 0, false); t = __builtin_amdgcn_cvt_pk_fp8_f32(h[6], h[7], t, true); w8.y = (unsigned)t; }
                *(u32x2*)(H8 + (size_t)tok * D + kcol + 32 * ks) = w8;
                u32x4 hh, hl;
                hh.x = pg8::cvt_pk_bf16(h[0], h[1]); hh.y = pg8::cvt_pk_bf16(h[2], h[3]); hh.z = pg8::cvt_pk_bf16(h[4], h[5]); hh.w = pg8::cvt_pk_bf16(h[6], h[7]);
                hl.x = pg8::cvt_pk_bf16(h[0] - blo(hh.x), h[1] - bhi(hh.x)); hl.y = pg8::cvt_pk_bf16(h[2] - blo(hh.y), h[3] - bhi(hh.y)); hl.z = pg8::cvt_pk_bf16(h[4] - blo(hh.z), h[5] - bhi(hh.z)); hl.w = pg8::cvt_pk_bf16(h[6] - blo(hh.w), h[7] - bhi(hh.w));
                const bf16x8_t fh = __builtin_bit_cast(bf16x8_t, hh), fl = __builtin_bit_cast(bf16x8_t, hl);
#pragma unroll
                for (int nb = 0; nb < 2; ++nb) {
                    acc[nb] = __builtin_amdgcn_mfma_f32_16x16x32_bf16(wh[nb][ks], fh, acc[nb], 0, 0, 0);
                    acc[nb] = __builtin_amdgcn_mfma_f32_16x16x32_bf16(wh[nb][ks], fl, acc[nb], 0, 0, 0);
                    acc[nb] = __builtin_amdgcn_mfma_f32_16x16x32_bf16(wl[nb][ks], fh, acc[nb], 0, 0, 0);
                }
            }
#pragma unroll
            for (int nb = 0; nb < 2; ++nb) *(LAS f32x4*)(lds + ((s * 8 + wave) * 2 + nb) * 1024 + lane * 16) = acc[nb];
#pragma unroll
            for (int ks = 0; ks < 4; ++ks) xw[ks] = xn[ks];
            p4 = pn4;
        }
        __syncthreads();
        if (wave < ni) {
            const int it = ib + wave, tok = gtok(grp.g, it * 16) + fr;
            float lg[8];
#pragma unroll
            for (int nb = 0; nb < 2; ++nb) { f32x4 sum = *(const f32x4*)(rb + 16 * nb + 4 * fq);
#pragma unroll
                for (int w = 0; w < 8; ++w) sum += *(const LAS f32x4*)(lds + ((wave * 8 + w) * 2 + nb) * 1024 + lane * 16);
#pragma unroll
                for (int jj = 0; jj < 4; ++jj) lg[4 * nb + jj] = sum[jj]; }
            float tv[4]; int ti[4];
#pragma unroll
            for (int k = 0; k < 4; ++k) {
                float bv = lg[0]; int bi = 4 * fq;
#pragma unroll
                for (int q = 1; q < 8; ++q) { const int eq = 16 * (q >> 2) + 4 * fq + (q & 3); if (lg[q] > bv) { bv = lg[q]; bi = eq; } }
#pragma unroll
                for (int o = 16; o < 64; o <<= 1) { const float ov = __shfl_xor(bv, o); const int oi = __shfl_xor(bi, o); if (ov > bv || (ov == bv && oi < bi)) { bv = ov; bi = oi; } }
                tv[k] = bv; ti[k] = bi;
#pragma unroll
                for (int q = 0; q < 8; ++q) { const int eq = 16 * (q >> 2) + 4 * fq + (q & 3); if (eq == bi) lg[q] = -3.0e38f; }
            }
            if (fq == 0) {
                const float e1 = __expf(tv[1] - tv[0]), e2 = __expf(tv[2] - tv[0]), e3 = __expf(tv[3] - tv[0]); const float rz = 1.f / (1.f + e1 + e2 + e3);
                *(f32x4*)(gate + (size_t)tok * 4) = (f32x4){rz, e1 * rz, e2 * rz, e3 * rz};
                const int lt = (it - it0) * 16 + fr;
#pragma unroll
                for (int k = 0; k < 4; ++k) { const unsigned lp = __hip_atomic_fetch_add(&hist[ti[k]], 1u, __ATOMIC_RELAXED, __HIP_MEMORY_SCOPE_WORKGROUP); sel_e[lt * 4 + k] = (unsigned short)ti[k]; sel_p[lt * 4 + k] = (unsigned short)lp; }
            }
        }
        __syncthreads();
    }
#undef RT_LOAD
    if (tid < NE) gbase[tid] = __hip_atomic_fetch_add(&cnt[tid], hist[tid], __ATOMIC_RELAXED, __HIP_MEMORY_SCOPE_AGENT);
    __syncthreads();
    for (int i = tid; i < 1024; i += 512) { const int ee = sel_e[i];
        if (ee != 0xffff) { const int lt = i >> 2, tk = gtok(grp.g, (it0 + (lt >> 4)) * 16) + (lt & 15); list[(size_t)ee * GCAP + gbase[ee] + sel_p[i]] = tk * 4 + (i & 3); } }
    __syncthreads();
}

__device__ __forceinline__ void group_tables(LAS int* misc, const unsigned* cnt, const Grp grp) {
    __syncthreads();
    int tid_ = MK_TID(grp); asm volatile("" : "+v"(tid_));
    if (tid_ < 32) misc[64 + tid_] = (int)__hip_atomic_load(cnt + tid_, __ATOMIC_RELAXED, __HIP_MEMORY_SCOPE_AGENT);
    __syncthreads();
    if (tid_ == 0) { int s = 0; for (int e = 0; e < 32; ++e) { misc[e] = s; s += (misc[64 + e] + 255) >> 8; } misc[32] = s; }
    __syncthreads();
}

constexpr int N_PHASES = 2 + 7 * NL;
__global__ void __launch_bounds__(512, 2) mk_fwd(Args a) {
    extern __shared__ __attribute__((aligned(16))) unsigned char lds_raw[];
    LAS unsigned char* lds = (LAS unsigned char*)lds_raw;
    LAS int* misc = (LAS int*)(lds + LDS_MISC);
    const int wv_ = __builtin_amdgcn_readfirstlane((int)threadIdx.x >> 6), G = gridDim.x, bx = blockIdx.x;
#define tid (wv_ * 64 + mk_lane())
    const int vcu = (G % 8 == 0) ? (bx % 8) * (G / 8) + bx / 8 : bx;
    Grp grp;
    if (G % 16 == 0) { grp.g = (bx >> 3) & 1; grp.v = (bx & 7) * (G / 16) + (bx >> 4); grp.c = (bx & 7) + 8 * (bx >> 4); } else { grp.g = bx & 1; grp.v = bx >> 1; grp.c = bx >> 1; }
    grp.n = G / 2; grp.w = wv_;
    if (tid < 4) misc[128 + tid] = 0;
    __syncthreads();
    unsigned* flags = (unsigned*)(a.ws + WS_CTL) + CW_FLAG;
#if MK_PER_PHASE
#define GRID_BAR() do { } while (0)
#define WAIT_FLAG(w) do { } while (0)
#define SET_FLAG(w) do { } while (0)
#else
    XcdBarrier bar = xcd_barrier_post((unsigned*)(a.ws + WS_CTL) + CW_BAR + grp.g * XCD_BAR_WORDS, (volatile LAS unsigned*)(misc + 128), (unsigned)grp.n, (unsigned)wv_);
#define GRID_BAR() xcd_barrier(bar)
#define SET_FLAG(w) do { if (grp.v == 0 && tid == 0) __hip_atomic_store(flags + 64 * (w), 1u, __ATOMIC_RELAXED, __HIP_MEMORY_SCOPE_AGENT); } while (0)
#define WAIT_FLAG(w) do { if (tid == 0) { unsigned sp_ = 0; while (__hip_atomic_load(flags + 64 * (w), __ATOMIC_RELAXED, __HIP_MEMORY_SCOPE_AGENT) == 0u) { __builtin_amdgcn_s_sleep(8); if (++sp_ > (1u << 22)) break; } \
        __builtin_amdgcn_fence(__ATOMIC_ACQUIRE, "agent"); asm volatile("s_waitcnt vmcnt(0)" ::: "memory"); } __syncthreads(); } while (0)
#endif
    const int lo = a.ph_lo, hi = a.ph_hi;
#ifndef PH_MASK
#define PH_MASK 0x3ff
#endif
#define PHM(j) (((PH_MASK) >> (j)) & 1)
#define IN(k) (lo <= (k) && (k) < hi)
#define SEAM(k) do { if ((k) + 1 < hi) GRID_BAR(); } while (0)
    unsigned char* ws = a.ws;
    bf16* H = (bf16*)(ws + WS_H); bf16* P = (bf16*)(ws + WS_P); bf16* Y = (bf16*)(ws + WS_Y); unsigned char* O8 = ws + WS_O; bf16* X = (bf16*)(ws + WS_X);
    unsigned char* HID8 = ws + WS_HID + (size_t)grp.g * GHIDROWS * FF;
    const float* MOD = (const float*)(ws + WS_MOD); const int* LISTG = (const int*)(ws + WS_LIST) + (size_t)grp.g * NE * GCAP;

    if (PHM(0) && IN(0)) {
        constexpr long L0_ITEMS = (long)NE * ((D / 128) * (2 * FF / 32) + (FF / 128) * (D / 32)), L0_SPLIT = L0_ITEMS / 2;
        if (grp.g == 0) { ph_prologue(lds, a, grp, 0); if (1 < hi) { GRID_BAR(); SET_FLAG(0); } ph_prologue(lds, a, grp, 1, L0_SPLIT, L0_ITEMS); if (1 < hi) { GRID_BAR(); SET_FLAG(1); WAIT_FLAG(3); } }
        else { ph_prologue(lds, a, grp, 3); ph_prologue(lds, a, grp, 1, 0, L0_SPLIT); if (1 < hi) { GRID_BAR(); SET_FLAG(3); WAIT_FLAG(0); } }
#if MK_PER_PHASE
        if (grp.g == 1) ph_prologue(lds, a, grp, 2);
#endif
    }
    constexpr long L1_EARLY2 = (G1_QHI < 10 && !G1_FP8) ? 1280 : 0;
    constexpr long L1_EARLY = 3072;
    for (int l = 0; l < NL; ++l) {
        const int base = 1 + 7 * l, ntok = l == 0 ? GTOK : GLAT;
        const unsigned* cnt = (const unsigned*)(ws + WS_CTL) + CW_CNT + (grp.g * NL + l) * 64;
        if (PHM(1) && IN(base + 0)) { ph_norm1(l, a, grp); SEAM(base + 0); }
        if (PHM(2) && IN(base + 1)) {
#if G1_FP8
            pg8::DenseOrder S; S.init(H, (const bf16*)(ws + WS_WIN + (size_t)l * DIN * D), GTOK, DIN, D / 2, grp.n, grp.c, grp.g);
            pg8::gemm_phase<pg8::EpiP, pg8::DenseOrder, false, true>(lds, D / 2, S, pg8::EpiP{P, a.in[12] + l * 64, (long)(a.in[13] - a.in[12])}, grp.w);
#else
            if (G1_QLO > 0) { pg8::DenseOrder S; S.init(H, (const bf16*)(ws + WS_WIN) + (size_t)l * DIN * D, GTOK, G1_QLO * 256, D, grp.n, grp.c, grp.g);
              pg8::gemm_phase<pg8::EpiPT<false, 0>, pg8::DenseOrder, false>(lds, D, S, pg8::EpiPT<false, 0>{P, a.in[12] + l * 64, (long)(a.in[13] - a.in[12])}, grp.w); }
            if (DINQ > 0) { pg8::DenseOrder S; S.init((const bf16*)(ws + WS_HQ), (const bf16*)(ws + WS_WINQ + (size_t)l * DINQ * D), GTOK, DINQ, D / 2, grp.n, grp.c, grp.g);
              pg8::gemm_phase<pg8::EpiPT<true, G1_QLO>, pg8::DenseOrder, false, true>(lds, D / 2, S, pg8::EpiPT<true, G1_QLO>{P, a.in[12] + l * 64, (long)(a.in[13] - a.in[12])}, grp.w); }
            if (G1_QHI < 10) { pg8::DenseOrder S; S.init(H, (const bf16*)(ws + WS_WIN) + (size_t)l * DIN * D + (size_t)G1_QHI * 256 * D, GTOK, (10 - G1_QHI) * 256, D, grp.n, grp.c, grp.g);
              pg8::gemm_phase<pg8::EpiPT<false, G1_QHI>, pg8::DenseOrder, false>(lds, D, S, pg8::EpiPT<false, G1_QHI>{P, a.in[12] + l * 64, (long)(a.in[13] - a.in[12])}, grp.w); }
#endif
#if !MK_PER_PHASE && !G1_FP8
            if (l == 1 && lo == 0 && G1_QHI < 10) { const int nun = (GTOK / 256) * (10 - G1_QHI), busy = nun % grp.n;
                if (busy != 0 && grp.c >= busy) { Grp gq = grp; gq.v = grp.c - busy; gq.n = grp.n - busy; __syncthreads(); ph_prologue(lds, a, gq, 2, 2 * L1_EARLY + (long)grp.g * L1_EARLY2, 2 * L1_EARLY + (long)(grp.g + 1) * L1_EARLY2); } }
#endif
            SEAM(base + 1);
#if !MK_PER_PHASE && !G1_FP8
            if (l == 1 && lo == 0 && G1_QHI < 10) SET_FLAG(5 + grp.g);
#endif
        }
        if (PHM(3) && IN(base + 2)) { ph_attn(lds, l, a, grp); ph_mix_a(lds, l, ntok, a, grp); ph_mix_c(lds, l, ntok, a, grp); ph_mix_d(l, ntok, a, grp); SEAM(base + 2); }
        if (PHM(5) && IN(base + 3)) {
            if (G2_FP8_L1 && l == NL - 1) {
                pg8::DenseOrder S; S.init((const bf16*)(ws + WS_Y8), (const bf16*)(ws + WS_WOUTQ), ntok, D, D / 2, grp.n, grp.c, grp.g);
                pg8::gemm_phase<pg8::EpiXT<true>, pg8::DenseOrder, false, true>(lds, D / 2, S, pg8::EpiXT<true>{X, l == 0 ? (const void*)a.in[0] : (const void*)X, l == 0 ? (const void*)a.in[2] : (const void*)(X + (size_t)NLAT * D), MOD + (size_t)l * 17 * MODW + 2 * D, (float*)(ws + WS_SS), l == 0 ? 1 : 0}, grp.w);
            } else {
                pg8::DenseOrder S; S.init(Y, (const bf16*)(ws + WS_WOUT) + (size_t)l * D * D, ntok, D, D, grp.n, grp.c, grp.g);
                pg8::gemm_phase<pg8::EpiX, pg8::DenseOrder, false>(lds, D, S, pg8::EpiX{X, l == 0 ? (const void*)a.in[0] : (const void*)X, l == 0 ? (const void*)a.in[2] : (const void*)(X + (size_t)NLAT * D), MOD + (size_t)l * 17 * MODW + 2 * D, (float*)(ws + WS_SS), l == 0 ? 1 : 0}, grp.w);
            }
#if !MK_PER_PHASE
            if (l == 0 && lo == 0) { const int nun = (ntok / 256) * (D / 256), busy = nun % grp.n;
                if (busy != 0 && grp.c >= busy) { Grp gq = grp; gq.v = grp.c - busy; gq.n = grp.n - busy; __syncthreads(); ph_prologue(lds, a, gq, 2, (long)grp.g * L1_EARLY, (long)(grp.g + 1) * L1_EARLY); } }
#endif
            SEAM(base + 3);
#if !MK_PER_PHASE
            if (l == 0 && lo == 0 && grp.g == 0) SET_FLAG(4);
#endif
        }
        if (PHM(6) && IN(base + 4)) { ph_route(lds, l, ntok, a, grp); SEAM(base + 4); }
        if (PHM(7) && IN(base + 5)) {
            if (lo == 0) { if (l == 0 && grp.g == 1) WAIT_FLAG(1); if (l == 1 && grp.g == 0) { WAIT_FLAG(2); WAIT_FLAG(6); } if (l == 1 && grp.g == 1) { WAIT_FLAG(4); WAIT_FLAG(5); } }
            group_tables(misc, cnt, grp);
            pg8::GroupOrder S{misc, misc + 64, (const char*)(ws + WS_H8), (const char*)(ws + WS_WGU) + (size_t)l * NE * 2 * FF * D, LISTG, (size_t)2 * FF * D, D / 2, 8, grp.n, grp.v, true};
            pg8::gemm_phase<pg8::EpiHid, pg8::GroupOrder, true, true>(lds, D / 2, S, pg8::EpiHid{(bf16*)HID8, a.in[28] + (size_t)l * NE * 2 * FF, misc}, grp.w, misc + 256);
            SEAM(base + 5);
        }
        if (PHM(8) && IN(base + 6)) {
            group_tables(misc, cnt, grp);
            pg8::GroupOrder S{misc, misc + 64, (const char*)HID8, (const char*)(ws + WS_WDN) + (size_t)l * NE * D * FF, LISTG, (size_t)D * FF, FF / 2, 4, grp.n, grp.v, false};
            pg8::gemm_phase<pg8::EpiO, pg8::GroupOrder, false, true>(lds, FF / 2, S, pg8::EpiO{O8, a.in[30] + (size_t)l * NE * D}, grp.w, misc + 256);
#if !MK_PER_PHASE
            if (l == 0 && grp.g == 1 && lo == 0) { __syncthreads(); ph_prologue(lds, a, grp, 2, 2 * L1_EARLY + 2 * L1_EARLY2); }
#endif
            SEAM(base + 6);
#if !MK_PER_PHASE
            if (l == 0 && grp.g == 1 && lo == 0) SET_FLAG(2);
#endif
        }
    }
    if (PHM(9) && IN(N_PHASES - 1)) ph_final(a, grp);
#undef IN
#undef SEAM
#undef GRID_BAR
#undef tid
}

extern "C" void kernel_launch(void* const* d_in, const int* in_sizes, int n_in, void* d_out, int out_size, void* d_ws, size_t ws_size, hipStream_t stream) {
    static int grid = 0;
    if (grid == 0) {
        if (n_in != 31 || ws_size < WS_END || out_size != NLAT * D) { fprintf(stderr, "kernel_launch: unexpected shapes (n_in %d, ws %zu, out %d)\n", n_in, ws_size, out_size); grid = -1; return; }
        int dev = 0, cus = 0, per_cu = 0;
        if (hipGetDevice(&dev) != hipSuccess || hipDeviceGetAttribute(&cus, hipDeviceAttributeMultiprocessorCount, dev) != hipSuccess || cus <= 0) { fprintf(stderr, "kernel_launch: device query failed\n"); grid = -1; return; }
        if (hipFuncSetAttribute((const void*)mk_fwd, hipFuncAttributeMaxDynamicSharedMemorySize, LDS_BYTES) != hipSuccess) { fprintf(stderr, "kernel_launch: hipFuncSetAttribute failed\n"); grid = -1; return; }
        if (hipOccupancyMaxActiveBlocksPerMultiprocessor(&per_cu, (const void*)mk_fwd, 512, LDS_BYTES) != hipSuccess || per_cu < 1) { fprintf(stderr, "kernel_launch: occupancy query reports %d workgroups per CU\n", per_cu); (void)hipGetLastError(); }
        grid = cus & ~15;
    }
    if (grid < 0) return;
    (void)hipMemsetAsync((unsigned char*)d_ws + WS_CTL, 0, CTL_BYTES, stream);
    Args a{};
    for (int i = 0; i < 31; ++i) a.in[i] = (const float*)d_in[i];
    a.out = (float*)d_out; a.ws = (unsigned char*)d_ws;
#if MK_PER_PHASE
    for (int p = 0; p < N_PHASES; ++p) { a.ph_lo = p; a.ph_hi = p + 1; hipLaunchKernelGGL(mk_fwd, dim3(grid), dim3(512), LDS_BYTES, stream, a); }
#else
    a.ph_lo = 0; a.ph_hi = N_PHASES;
    hipLaunchKernelGGL(mk_fwd, dim3(grid), dim3(512), LDS_BYTES, stream, a);
#endif
}
```

```cpp
#include <hip/hip_runtime.h>
#include <cstdio>
#include <cstdint>
#ifndef G1_FP8
#define G1_FP8 0
#endif
#ifndef G1_QLO
#define G1_QLO 0
#define G1_QHI 7
#endif
#ifndef MK_PER_PHASE
#define MK_PER_PHASE 0
#endif

typedef unsigned short bf16;
typedef float f32x4 __attribute__((ext_vector_type(4)));
typedef float f32x2 __attribute__((ext_vector_type(2)));
typedef unsigned u32x4 __attribute__((ext_vector_type(4)));
typedef unsigned u32x2 __attribute__((ext_vector_type(2)));
typedef short bf16x8_t __attribute__((ext_vector_type(8)));
typedef short v4i16_t __attribute__((ext_vector_type(4)));

constexpr int D = 1024, NB = 16, SEQ = 2048, NL = 2, CTXL = 256;
constexpr int NLAT = NB * SEQ, NCTX = NB * CTXL, NTOK = NLAT + NCTX;
constexpr int GW = 256, DIN = 2560, NE = 32, TOPK = 4, FF = 1024;
constexpr int DINP = 2048;
constexpr int NSLOT = NTOK * TOPK;
constexpr int HIDROWS = NSLOT + NE * 256;
constexpr int CAP = NTOK;
constexpr int NKEY = SEQ + CTXL;
constexpr float EPS = 1e-6f;
constexpr int NGRP = 2, GLAT = NLAT / NGRP, GCTX = NCTX / NGRP, GTOK = GLAT + GCTX, GCAP = GTOK, GHIDROWS = GTOK * TOPK + NE * 256;
struct Grp { int g, v, n, c, w; };
__device__ __forceinline__ int mk_lane() { int r; asm volatile("v_mbcnt_lo_u32_b32 %0, -1, 0\n\tv_mbcnt_hi_u32_b32 %0, -1, %0" : "=v"(r)); return r; }
#define MK_TID(grp) ((grp).w * 64 + mk_lane())
constexpr int MODW = 6 * D;

constexpr size_t MiB = 1u << 20;
constexpr size_t WS_CTL = 0, CTL_BYTES = 1 * MiB;
constexpr size_t WS_MOD = 1 * MiB;
constexpr size_t WS_X = 2 * MiB;
constexpr size_t WS_H = WS_X + 144 * MiB;
constexpr size_t WS_HQ = WS_X + 108 * MiB;
constexpr size_t WS_H8 = WS_X + 72 * MiB;
constexpr size_t WS_P = WS_H + 72 * MiB;
constexpr size_t WS_Y = WS_P + 180 * MiB;
constexpr size_t WS_HID = WS_Y + 72 * MiB;
constexpr size_t WS_O = WS_HID + 304 * MiB;
constexpr size_t WS_LIST = WS_O + 288 * MiB;
constexpr size_t WS_GATE = WS_LIST + 5 * MiB;
constexpr size_t WS_WIN = WS_GATE + 1 * MiB;
constexpr size_t WS_WOUT = WS_WIN + 10 * MiB;
constexpr size_t WS_WGU = WS_WOUT + 4 * MiB;
constexpr size_t WS_WDN = WS_WGU + 256 * MiB;
constexpr int DINQ = (G1_QHI - G1_QLO) * 256;
constexpr size_t WS_WINQ = WS_WDN + 128 * MiB;
constexpr size_t WS_VT = WS_WDN + 128 * MiB;
constexpr size_t WS_RWT = WS_VT + 20 * MiB;
constexpr size_t WS_SS = WS_RWT + 1 * MiB;
constexpr size_t WS_END = WS_SS + 3 * MiB;
constexpr int CW_CNT = 64;
constexpr int CW_BAR = 4096;
constexpr int CW_FLAG = 2048;

__device__ __forceinline__ float bf2f(bf16 v) { return __uint_as_float(((unsigned)v) << 16); }
__device__ __forceinline__ bf16 f2bf(float f) { unsigned u = __float_as_uint(f); return (bf16)((u + 0x7fffu + ((u >> 16) & 1u)) >> 16); }
__device__ __forceinline__ unsigned pk2(float lo, float hi) { return (unsigned)f2bf(lo) | ((unsigned)f2bf(hi) << 16); }
__device__ __forceinline__ float blo(unsigned w) { return __uint_as_float(w << 16); }
__device__ __forceinline__ float bhi(unsigned w) { return __uint_as_float(w & 0xffff0000u); }
__device__ __forceinline__ float sigmoid_f(float x) { return __builtin_amdgcn_rcpf(1.f + __builtin_amdgcn_exp2f(-1.44269504089f * x)); }
__device__ __forceinline__ float silu_f(float x) { return x * sigmoid_f(x); }
__device__ __forceinline__ float gelu_tanh(float x) { const float u = 0.7978845608f * (x + 0.044715f * x * x * x); return x * sigmoid_f(2.f * u); }
__device__ __forceinline__ int tok_modrow(int tok) { return tok < NLAT ? (tok >> 11) : 16; }
__device__ __forceinline__ int gtok(int g, int t) { return t < GLAT ? g * GLAT + t : NLAT + g * GCTX + (t - GLAT); }
__device__ __forceinline__ float wave_sum(float v) {
#pragma unroll
    for (int o = 1; o < 64; o <<= 1) v += __shfl_xor(v, o);
    return v;
}
__device__ __forceinline__ float wave_max(float v) {
#pragma unroll
    for (int o = 1; o < 64; o <<= 1) v = fmaxf(v, __shfl_xor(v, o));
    return v;
}
__device__ __forceinline__ float lam_init_of(int l) { return l == 0 ? 0.2f : 0.35550906f; }
#define LDS_WAIT() asm volatile("s_waitcnt lgkmcnt(0)" ::: "memory")
#define VM_WAIT() asm volatile("s_waitcnt vmcnt(0)" ::: "memory")

#define LAS __attribute__((address_space(3)))
#ifndef PG8_ALIGN_DEFAULT
#define PG8_ALIGN_DEFAULT true
#endif
namespace pg8 {
typedef short bf16x8 __attribute__((ext_vector_type(8)));
typedef int v4i_t __attribute__((ext_vector_type(4)));
typedef int v8i_t __attribute__((ext_vector_type(8)));
constexpr int BM = 256, BK = 64, HALF = 128, HTB = HALF * BK * 2, STAGE_BYTES = 8 * HTB;
__host__ __device__ __forceinline__ int lds_byte(int r, int c) { const int st = (r >> 4) * 2 + (c >> 5), rr = r & 15, cc = c & 31, ob = rr * 64 + cc * 2; return st * 1024 + (ob ^ (((ob >> 9) & 1) << 5)); }
__host__ __device__ __forceinline__ void stage_rc(int b, int& R, int& C) { const int st = b / 1024, sb = b % 1024, swz = sb ^ (((sb >> 9) & 1) << 5); R = (st >> 1) * 16 + swz / 64; C = (st & 1) * 32 + (swz % 64) / 2; }
__host__ __device__ __forceinline__ int perm32(int rho) { const int n = rho >> 4, i = rho & 15; return 8 * (i >> 2) + 4 * n + (i & 3); }
__device__ __forceinline__ void mfma_fp8(f32x4& acc, const v8i_t& b, const v8i_t& a, int sc) {
    asm volatile("v_mfma_scale_f32_16x16x128_f8f6f4 %0, %1, %2, %0, %3, %3 op_sel_hi:[0,0,0]" : "+v"(acc) : "v"(b), "v"(a), "v"(sc));
}
__device__ __forceinline__ void glds16_s(const void* sbase, unsigned voff, unsigned lds_dst) {
    unsigned keep;
    asm volatile("s_mov_b32 %0, m0\n\ts_mov_b32 m0, %3\n\ts_nop 0\n\tglobal_load_lds_dwordx4 %1, %2\n\ts_mov_b32 m0, %0" : "=&s"(keep) : "v"(voff), "s"(sbase), "s"(lds_dst) : "memory");
}
__device__ __forceinline__ unsigned cvt_pk_bf16(float lo, float hi) { unsigned r; asm volatile("v_cvt_pk_bf16_f32 %0, %1, %2" : "=v"(r) : "v"(lo), "v"(hi)); return r; }

struct GU { const char* a; const char* b; const int* rows; const LAS int* tab; int pm, pn, e, nvalid; };

template <class Epi, class Sched, bool GATHER, bool FP8 = false, int STAGGER = 0, bool ALIGN = PG8_ALIGN_DEFAULT>
__device__ __forceinline__ void gemm_phase(LAS unsigned char* lds, const int K, const Sched& S, const Epi& E, const int wv, LAS int* rowtab = nullptr) {
    int tid_ = wv * 64 + mk_lane(); asm volatile("" : "+v"(tid_));
    const int tid = tid_, wid = __builtin_amdgcn_readfirstlane(tid >> 6), lane = tid & 63, wr = wid >> 2, wc = wid & 3, fr = lane & 15, fq = lane >> 4;
    const int nt = K / BK;
    unsigned voffB[2];
#pragma unroll
    for (int i = 0; i < 2; ++i) { int R_, C_; stage_rc(tid * 16 + i * 8192, R_, C_); const int Rb = Epi::PERM ? ((R_ & ~31) + perm32(R_ & 31)) : R_; voffB[i] = (unsigned)(Rb * K + C_) * 2u; }
    const size_t kstep = (size_t)(BK * 2), hstep = (size_t)HALF * K * 2;
    const unsigned ldsb = (unsigned)__builtin_amdgcn_readfirstlane((int)(unsigned)(size_t)lds + wid * 1024);
    const int aoff = lds_byte(wr * 64 + fr, fq * 8), boff = lds_byte(wc * 32 + fr, fq * 8);
#define PG8_SA(b, h) (((b) * 2 + (h)) * HTB)
#define PG8_SB(b, h) ((4 + (b) * 2 + (h)) * HTB)
#define PG8_STAGE(bufoff, gbase, voff) do { _Pragma("unroll") for (int _i = 0; _i < 2; ++_i) \
        glds16_s((const void*)(gbase), (voff)[_i], ldsb + (unsigned)((bufoff) + _i * 8192)); } while (0)
#define PG8_LDA(dst, b, h) do { _Pragma("unroll") for (int m = 0; m < 4; ++m) dst[m] = __builtin_shufflevector(*(const LAS v4i_t*)(lds + PG8_SA(b, h) + aoff + m * 2048), *(const LAS v4i_t*)(lds + PG8_SA(b, h) + aoff + m * 2048 + 1024), 0, 1, 2, 3, 4, 5, 6, 7); } while (0)
#define PG8_LDB(dst, b, h) do { _Pragma("unroll") for (int n = 0; n < 2; ++n) dst[n] = __builtin_shufflevector(*(const LAS v4i_t*)(lds + PG8_SB(b, h) + boff + n * 2048), *(const LAS v4i_t*)(lds + PG8_SB(b, h) + boff + n * 2048 + 1024), 0, 1, 2, 3, 4, 5, 6, 7); } while (0)
#define PG8_MMA(ai, bj, At, Bt) do { __builtin_amdgcn_s_setprio(1); _Pragma("unroll") for (int m = 0; m < 4; ++m) _Pragma("unroll") for (int n = 0; n < 2; ++n) { \
        if (FP8) mfma_fp8(acc[ai][bj][m][n], Bt[n], At[m], sc8); \
        else { acc[ai][bj][m][n] = __builtin_amdgcn_mfma_f32_16x16x32_bf16(__builtin_bit_cast(bf16x8, __builtin_shufflevector(Bt[n], Bt[n], 0, 1, 2, 3)), __builtin_bit_cast(bf16x8, __builtin_shufflevector(At[m], At[m], 0, 1, 2, 3)), acc[ai][bj][m][n], 0, 0, 0); \
               acc[ai][bj][m][n] = __builtin_amdgcn_mfma_f32_16x16x32_bf16(__builtin_bit_cast(bf16x8, __builtin_shufflevector(Bt[n], Bt[n], 4, 5, 6, 7)), __builtin_bit_cast(bf16x8, __builtin_shufflevector(At[m], At[m], 4, 5, 6, 7)), acc[ai][bj][m][n], 0, 0, 0); } } __builtin_amdgcn_s_setprio(0); } while (0)
#define PG8_WAIT_V(n) asm volatile("s_waitcnt vmcnt(" #n ")" ::: "memory")
#define PG8_WAIT_L(n) asm volatile("s_waitcnt lgkmcnt(" #n ")" ::: "memory")
#define PG8_BAR __builtin_amdgcn_s_barrier()
#define PG8_SCHED __builtin_amdgcn_sched_barrier(0)
#define PG8_AOFF(dst, u) do { _Pragma("unroll") for (int _h = 0; _h < 2; ++_h) _Pragma("unroll") for (int _i = 0; _i < 2; ++_i) { int _R, _C; stage_rc(tid * 16 + _i * 8192, _R, _C); \
        if (GATHER) { int _r = _h * HALF + _R; _r = _r < (u).nvalid ? _r : (u).nvalid - 1; dst[_h][_i] = ((unsigned)((u).tab[_r] >> 2) * (unsigned)K + (unsigned)_C) * 2u; } \
        else dst[_h][_i] = (unsigned)(_R * K + _C) * 2u; } } while (0)
#define PG8_AH(h) (GATHER ? (size_t)0 : (size_t)(h) * hstep)
    GU cur, nxt; int ui = 0;
    if (!S.next(0, cur)) return;
    for (int s_ = 0; s_ < (S.c & 7) * STAGGER; ++s_) __builtin_amdgcn_s_sleep(56);
    f32x4 acc[2][2][4][2];
#pragma unroll
    for (int a = 0; a < 2; ++a)
#pragma unroll
        for (int b = 0; b < 2; ++b)
#pragma unroll
            for (int m = 0; m < 4; ++m)
#pragma unroll
                for (int n = 0; n < 2; ++n) acc[a][b][m][n] = (f32x4){0.f, 0.f, 0.f, 0.f};
    v8i_t At[4], B0[2], B1[2];
    typename Epi::Pre pre;
    int sc8 = 0x7f7f7f7f; asm volatile("" : "+v"(sc8));
    unsigned ao[2][2], an[2][2];
#define PG8_TABDMA(u, slot) do { if (rowtab != nullptr && wid == 0) glds16_s((const void*)(u).rows, (unsigned)mk_lane() * 16u, (unsigned)__builtin_amdgcn_readfirstlane((int)(unsigned)(size_t)(rowtab + (slot) * 256))); } while (0)
    cur.tab = rowtab; nxt.tab = rowtab;
    if (rowtab != nullptr) { PG8_TABDMA(cur, 0); PG8_WAIT_V(0); PG8_BAR; }
    PG8_AOFF(ao, cur);
    const char* cA = cur.a; const char* cB = cur.b;
    PG8_STAGE(PG8_SB(0, 0), cB, voffB); PG8_STAGE(PG8_SB(0, 1), cB + hstep, voffB); PG8_STAGE(PG8_SA(0, 0), cA, ao[0]); PG8_STAGE(PG8_SA(0, 1), cA + PG8_AH(1), ao[1]);
    if (wr == 1) PG8_BAR;
    PG8_WAIT_V(2); PG8_BAR;
    PG8_STAGE(PG8_SB(1, 0), cB + kstep, voffB); PG8_STAGE(PG8_SA(1, 0), cA + kstep, ao[0]); PG8_STAGE(PG8_SB(1, 1), cB + hstep + kstep, voffB);
    PG8_WAIT_V(6); PG8_BAR;
    for (;;) {
        const bool has_next = S.next(ui + 1, nxt);
        if (rowtab != nullptr) nxt.tab = rowtab + ((ui + 1) % 3) * 256;
        if (has_next) PG8_TABDMA(nxt, (ui + 1) % 3);
#pragma unroll
        for (int h = 0; h < 2; ++h)
#pragma unroll
            for (int i = 0; i < 2; ++i) an[h][i] = ao[h][i];
        const char* nA = has_next ? nxt.a : cA; const char* nB = has_next ? nxt.b : cB;
#pragma unroll 1
        for (int t = 0; t < nt; t += 2) {
            const bool last = (t == nt - 2);
            const char* a1 = cA + (size_t)(t + 1) * kstep;
            const char* a2 = last ? nA : cA + (size_t)(t + 2) * kstep; const char* b2 = last ? nB : cB + (size_t)(t + 2) * kstep;
            const char* a3 = a2 + kstep; const char* b3 = b2 + kstep;
            if (last) E.prefetch(pre, cur, wr, wc, fr, fq);
            if (GATHER && last && has_next) PG8_AOFF(an, nxt);
            unsigned o2[2][2];
#pragma unroll
            for (int h = 0; h < 2; ++h)
#pragma unroll
                for (int i = 0; i < 2; ++i) o2[h][i] = (GATHER && last) ? an[h][i] : ao[h][i];
            PG8_LDB(B0, 0, 0); PG8_LDB(B1, 0, 1); PG8_SCHED; PG8_LDA(At, 0, 0); PG8_STAGE(PG8_SA(1, 1), a1 + PG8_AH(1), ao[1]);
            PG8_WAIT_V(8); PG8_WAIT_L(0); PG8_BAR; PG8_MMA(0, 0, At, B0); PG8_MMA(0, 1, At, B1); PG8_BAR; PG8_SCHED;
            PG8_LDA(At, 0, 1); PG8_STAGE(PG8_SB(0, 0), b2, voffB); PG8_STAGE(PG8_SB(0, 1), b2 + hstep, voffB); PG8_STAGE(PG8_SA(0, 0), a2, o2[0]);
            PG8_WAIT_V(8); PG8_WAIT_L(0); PG8_BAR; if (!FP8 || cur.nvalid > HALF) { PG8_MMA(1, 0, At, B0); PG8_MMA(1, 1, At, B1); } PG8_BAR; PG8_SCHED;
            PG8_LDB(B0, 1, 0); PG8_LDB(B1, 1, 1); PG8_SCHED; PG8_LDA(At, 1, 0); PG8_STAGE(PG8_SA(0, 1), a2 + PG8_AH(1), o2[1]);
            PG8_WAIT_V(8); PG8_WAIT_L(0); PG8_BAR; PG8_MMA(0, 0, At, B0); PG8_MMA(0, 1, At, B1); PG8_BAR; PG8_SCHED;
            PG8_LDA(At, 1, 1); PG8_STAGE(PG8_SB(1, 0), b3, voffB); PG8_STAGE(PG8_SB(1, 1), b3 + hstep, voffB); PG8_STAGE(PG8_SA(1, 0), a3, o2[0]);
            PG8_WAIT_V(8); PG8_WAIT_L(0); PG8_BAR; if (!FP8 || cur.nvalid > HALF) { PG8_MMA(1, 0, At, B0); PG8_MMA(1, 1, At, B1); } PG8_BAR; PG8_SCHED;
        }
        if (ALIGN) { if (wr == 0) PG8_BAR; }
        if (FP8) asm volatile("s_nop 15\n\ts_nop 15" ::: "memory");
        E(acc, cur, wr, wc, fr, fq, pre);
        if (!has_next) break;
#pragma unroll
        for (int a = 0; a < 2; ++a)
#pragma unroll
            for (int b = 0; b < 2; ++b)
#pragma unroll
                for (int m = 0; m < 4; ++m)
#pragma unroll
                    for (int n = 0; n < 2; ++n) acc[a][b][m][n] = (f32x4){0.f, 0.f, 0.f, 0.f};
        cur = nxt; cA = nA; cB = nB; ++ui;
#pragma unroll
        for (int h = 0; h < 2; ++h)
#pragma unroll
            for (int i = 0; i < 2; ++i) ao[h][i] = an[h][i];
        if (ALIGN) { if (wr == 1) PG8_BAR; }
    }
    PG8_WAIT_V(0);
    if (!ALIGN) { if (wr == 0) PG8_BAR; }
    PG8_BAR;
#undef PG8_SA
#undef PG8_SB
#undef PG8_STAGE
#undef PG8_LDA
#undef PG8_LDB
#undef PG8_MMA
#undef PG8_WAIT_V
#undef PG8_WAIT_L
#undef PG8_BAR
#undef PG8_SCHED
#undef PG8_AOFF
#undef PG8_TABDMA
#undef PG8_AH
}

struct DenseOrder {
    const char* A; const char* Bt; int K, nM, nN, nwg, G, c, g;
    __device__ __forceinline__ void init(const bf16* A_, const bf16* Bt_, int M, int N, int K_, int G_, int c_, int g_) { A = (const char*)A_; Bt = (const char*)Bt_; K = K_; nM = M / BM; nN = N / BM; nwg = nM * nN; G = G_; c = c_; g = g_; }
    __device__ __forceinline__ bool next(int i, GU& u) const {
        const long L = (long)i * G + c; if (L >= nwg) return false;
        int wgid = (int)L; { const int q = nwg / 8, r = nwg % 8, xcd = wgid % 8, off = wgid / 8; wgid = (xcd < r ? xcd * (q + 1) : r * (q + 1) + (xcd - r) * q) + off; }
        const int nig = 8 * nN, gid = wgid / nig, fm = gid * 8, gsz = (nM - fm) < 8 ? (nM - fm) : 8;
        const int pml = fm + ((wgid % nig) % gsz); u.pm = pml < GLAT / BM ? g * (GLAT / BM) + pml : NLAT / BM + g * (GCTX / BM) + (pml - GLAT / BM);
        u.pn = (wgid % nig) / gsz; u.e = 0; u.nvalid = 256; u.rows = nullptr; u.tab = nullptr;
        u.a = A + (size_t)u.pm * BM * K * 2; u.b = Bt + (size_t)u.pn * BM * K * 2; return true;
    }
};
struct GroupOrder {
    const LAS int* tb; const LAS int* cn; const char* A; const char* Bt; const int* list; size_t bstride; int K, NT, G, c; bool gather;
    __device__ __forceinline__ bool next(int i, GU& u) const {
        const int T = __builtin_amdgcn_readfirstlane(tb[32]), per = G >> 3, x = c / per, j = c - x * per, tlo = (T * x) >> 3, thi = (T * (x + 1)) >> 3, q = i * per + j;
        if (q >= (thi - tlo) * NT) return false;
        int lane_ = mk_lane(); asm volatile("" : "+v"(lane_)); const int tile = tlo + q / NT, pn = q % NT, lane = lane_;
        const unsigned long long bal = __ballot(lane < 32 && tb[(lane & 31) + 1] <= tile);
        const int e = __builtin_amdgcn_readfirstlane(__builtin_popcountll(bal)), mt = tile - __builtin_amdgcn_readfirstlane(tb[e]);
        u.e = e; u.pm = mt; u.pn = pn; const int left = __builtin_amdgcn_readfirstlane(cn[e]) - mt * 256; u.nvalid = left < 256 ? left : 256; u.rows = list + (size_t)e * GCAP + mt * 256;
        u.b = Bt + (size_t)e * bstride + (size_t)pn * BM * K * 2;
        u.a = gather ? A : A + (size_t)tile * BM * K * 2;
        return true;
    }
};

template <bool F8, int PN0> struct EpiPT {
    static constexpr bool PERM = true; static constexpr float sc = F8 ? 1.f / 64.f : 1.f; bf16* P; const float* qg; long kdelta;
    __device__ __forceinline__ void qk_unit(const f32x4 (&acc)[2][2][4][2], const GU& u, int wr, int wc, int fr, int fq) const {
        const int row0 = u.pm * BM + wr * 64 + fr, cw = wc * 32 + 8 * fq, isq = (u.pn + PN0) == 2, odd = fq & 1;
        const bool lat = u.pm * BM < NLAT;
        const float* gp = qg + (isq ? 0L : kdelta) + (wc & 1) * 32 + 8 * fq;
        const f32x4 g0 = *(const f32x4*)gp, g1 = *(const f32x4*)(gp + 4);
        const float qs = isq ? 0.17677669529f * 1.44269504089f : 1.f;
#pragma unroll
        for (int ai = 0; ai < 2; ++ai)
#pragma unroll
            for (int m = 0; m < 4; ++m) {
                const int tok = row0 + ai * HALF + m * 16, s = tok & 2047; const float pos = (float)(fq < 2 ? (s >> 6) : (s & 63));
                float cs[8], sn[8];
#pragma unroll
                for (int j = 0; j < 8; ++j) { const float invj = j == 0 ? 1.f : j == 1 ? 0.316227766f : j == 2 ? 0.1f : j == 3 ? 0.0316227766f : j == 4 ? 0.01f : j == 5 ? 0.00316227766f : j == 6 ? 0.001f : 0.000316227766f; float rr = pos * invj * 0.15915494309f; rr -= rintf(rr); cs[j] = lat ? __builtin_amdgcn_cosf(rr) : 1.f; sn[j] = lat ? __builtin_amdgcn_sinf(rr) : 0.f; }
#pragma unroll
                for (int bj = 0; bj < 2; ++bj) {
                    float x[8]; float ss = 0.f;
#pragma unroll
                    for (int n = 0; n < 2; ++n)
#pragma unroll
                        for (int q = 0; q < 4; ++q) { x[4 * n + q] = acc[ai][bj][m][n][q] * sc; ss += x[4 * n + q] * x[4 * n + q]; }
                    ss += __shfl_xor(ss, 16); ss += __shfl_xor(ss, 32);
                    const float rstd = rsqrtf(ss * (1.f / 32.f) + EPS);
                    float o[8];
#pragma unroll
                    for (int j = 0; j < 8; ++j) { const float y = x[j] * rstd * (j < 4 ? g0[j & 3] : g1[j & 3]), p = __shfl_xor(y, 16); o[j] = (odd ? (p * sn[j] + y * cs[j]) : (y * cs[j] - p * sn[j])) * qs; }
                    u32x4 w; w.x = cvt_pk_bf16(o[0], o[1]); w.y = cvt_pk_bf16(o[2], o[3]); w.z = cvt_pk_bf16(o[4], o[5]); w.w = cvt_pk_bf16(o[6], o[7]);
                    *(u32x4*)(P + (size_t)tok * DINP + (u.pn + PN0) * BM + bj * HALF + cw) = w;
                }
            }
    }
    struct Pre {};
    __device__ __forceinline__ void prefetch(Pre&, const GU&, int, int, int, int) const {}
    __device__ __forceinline__ void operator()(const f32x4 (&acc)[2][2][4][2], const GU& u, int wr, int wc, int fr, int fq, const Pre&) const {
        if ((u.pn + PN0) == 2 || (u.pn + PN0) == 3) { qk_unit(acc, u, wr, wc, fr, fq); return; }
        const int row0 = u.pm * BM + wr * 64 + fr, cw = wc * 32 + 8 * fq;
        const int kind = ((u.pn + PN0) == 5 || (u.pn + PN0) == 6) ? 1 : (((u.pn + PN0) >= 8) ? 2 : 0);
        const int cbase = kind == 0 ? ((u.pn + PN0) < 5 ? (u.pn + PN0) * BM : 1536) : (kind == 1 ? 1280 + ((u.pn + PN0) - 5) * HALF : 1792 + ((u.pn + PN0) - 8) * HALF);
#pragma unroll
        for (int ai = 0; ai < 2; ++ai)
#pragma unroll
            for (int m = 0; m < 4; ++m) { bf16* rowp = P + (size_t)(row0 + ai * HALF + m * 16) * DINP + cbase + cw;
                if (kind == 0) {
#pragma unroll
                    for (int bj = 0; bj < 2; ++bj) { const f32x4 v0 = acc[ai][bj][m][0] * sc, v1 = acc[ai][bj][m][1] * sc;
                        u32x4 w; w.x = cvt_pk_bf16(v0[0], v0[1]); w.y = cvt_pk_bf16(v0[2], v0[3]); w.z = cvt_pk_bf16(v1[0], v1[1]); w.w = cvt_pk_bf16(v1[2], v1[3]);
                        *(u32x4*)(rowp + bj * HALF) = w; }
                } else {
                    float o[8];
#pragma unroll
                    for (int n = 0; n < 2; ++n)
#pragma unroll
                        for (int q = 0; q < 4; ++q) { const float a = acc[ai][0][m][n][q] * sc, g = acc[ai][1][m][n][q] * sc;
                            o[4 * n + q] = kind == 1 ? a * __builtin_amdgcn_rcpf(1.f + __builtin_amdgcn_exp2f(-1.44269504089f * g)) : a * g; }
                    u32x4 w; w.x = cvt_pk_bf16(o[0], o[1]); w.y = cvt_pk_bf16(o[2], o[3]); w.z = cvt_pk_bf16(o[4], o[5]); w.w = cvt_pk_bf16(o[6], o[7]);
                    *(u32x4*)rowp = w;
                }
            }
    }
};
typedef EpiPT<(G1_FP8 != 0), 0> EpiP;
struct EpiX {
    static constexpr bool PERM = true; bf16* X; const void* R0; const void* R1; const float* g1; float* SS; int rf32;
    struct Pre { f32x4 gv[2][2]; };
    __device__ __forceinline__ void prefetch(Pre& p, const GU& u, int wr, int wc, int fr, int fq) const {
        const float* g = g1 + (size_t)tok_modrow(u.pm * BM) * MODW + u.pn * BM + wc * 32 + 8 * fq;
#pragma unroll
        for (int bj = 0; bj < 2; ++bj)
#pragma unroll
            for (int n = 0; n < 2; ++n) p.gv[bj][n] = *(const f32x4*)(g + bj * HALF + 4 * n);
    }
    __device__ __forceinline__ void operator()(const f32x4 (&acc)[2][2][4][2], const GU& u, int wr, int wc, int fr, int fq, const Pre& pre) const {
        const int row0 = u.pm * BM + wr * 64 + fr, col0 = u.pn * BM + wc * 32 + 8 * fq;
        const bool lat = u.pm * BM < NLAT; const size_t roff = (size_t)(lat ? row0 : row0 - NLAT) * D + col0;
        const f32x4 (&gv)[2][2] = pre.gv;
#pragma unroll
        for (int ai = 0; ai < 2; ++ai) {
            f32x4 rv[4][2][2];
            if (rf32) { const float* R = (const float*)(lat ? R0 : R1) + roff;
#pragma unroll
                for (int m = 0; m < 4; ++m)
#pragma unroll
                    for (int bj = 0; bj < 2; ++bj)
#pragma unroll
                        for (int n = 0; n < 2; ++n) rv[m][bj][n] = *(const f32x4*)(R + (size_t)(ai * HALF + m * 16) * D + bj * HALF + 4 * n);
            } else { const bf16* R = (const bf16*)(lat ? R0 : R1) + roff; u32x4 rw[4][2];
#pragma unroll
                for (int m = 0; m < 4; ++m)
#pragma unroll
                    for (int bj = 0; bj < 2; ++bj) rw[m][bj] = *(const u32x4*)(R + (size_t)(ai * HALF + m * 16) * D + bj * HALF);
#pragma unroll
                for (int m = 0; m < 4; ++m)
#pragma unroll
                    for (int bj = 0; bj < 2; ++bj) { const u32x4 w = rw[m][bj]; rv[m][bj][0] = (f32x4){blo(w.x), bhi(w.x), blo(w.y), bhi(w.y)}; rv[m][bj][1] = (f32x4){blo(w.z), bhi(w.z), blo(w.w), bhi(w.w)}; }
            }
#pragma unroll
            for (int m = 0; m < 4; ++m) { bf16* rowp = X + (size_t)(row0 + ai * HALF + m * 16) * D + col0; float ssq = 0.f;
#pragma unroll
                for (int bj = 0; bj < 2; ++bj) { const f32x4 v0 = rv[m][bj][0] + gv[bj][0] * acc[ai][bj][m][0], v1 = rv[m][bj][1] + gv[bj][1] * acc[ai][bj][m][1];
                    ssq += (v0[0] * v0[0] + v0[1] * v0[1]) + (v0[2] * v0[2] + v0[3] * v0[3]) + (v1[0] * v1[0] + v1[1] * v1[1]) + (v1[2] * v1[2] + v1[3] * v1[3]);
                    u32x4 w; w.x = cvt_pk_bf16(v0[0], v0[1]); w.y = cvt_pk_bf16(v0[2], v0[3]); w.z = cvt_pk_bf16(v1[0], v1[1]); w.w = cvt_pk_bf16(v1[2], v1[3]);
                    *(u32x4*)(rowp + bj * HALF) = w; }
                ssq += __shfl_xor(ssq, 16); ssq += __shfl_xor(ssq, 32);
                if (fq == 0) SS[(size_t)(row0 + ai * HALF + m * 16) * 16 + 4 * u.pn + wc] = ssq; }
        }
    }
};
constexpr float W8_SCALE = 64.f, HID_SCALE = 4.f, O8_SCALE = 8.f;
struct EpiHid {
    static constexpr bool PERM = true; bf16* HID; const float* bgu; const LAS int* tb;
    struct Pre { f32x4 bgl[2], bup[2]; };
    __device__ __forceinline__ void prefetch(Pre& p, const GU& u, int wr, int wc, int fr, int fq) const {
        const float* bg = bgu + (size_t)u.e * 2 * FF + u.pn * HALF + wc * 32 + 8 * fq;
#pragma unroll
        for (int n = 0; n < 2; ++n) { p.bgl[n] = *(const f32x4*)(bg + 4 * n); p.bup[n] = *(const f32x4*)(bg + FF + 4 * n); }
    }
    __device__ __forceinline__ void operator()(const f32x4 (&acc)[2][2][4][2], const GU& u, int wr, int wc, int fr, int fq, const Pre& pre) const {
        const int row0 = (__builtin_amdgcn_readfirstlane(tb[u.e]) + u.pm) * BM + wr * 64 + fr, j0 = u.pn * HALF + wc * 32 + 8 * fq;
        const f32x4 (&bgl)[2] = pre.bgl; const f32x4 (&bup)[2] = pre.bup;
        const int odd = fq & 1;
#pragma unroll
        for (int ai = 0; ai < 2; ++ai)
#pragma unroll
            for (int mp = 0; mp < 2; ++mp) {
                u32x2 w[2];
#pragma unroll
                for (int t = 0; t < 2; ++t) { const int m = 2 * mp + t; float hv[8];
#pragma unroll
                    for (int n = 0; n < 2; ++n)
#pragma unroll
                        for (int q = 0; q < 4; q += 2) {
                            typedef float f2 __attribute__((ext_vector_type(2)));
                            f2 gl = (f2){acc[ai][0][m][n][q], acc[ai][0][m][n][q + 1]} * (1.f / W8_SCALE) + (f2){bgl[n][q], bgl[n][q + 1]};
                            f2 up = (f2){acc[ai][1][m][n][q], acc[ai][1][m][n][q + 1]} * (1.f / W8_SCALE) + (f2){bup[n][q], bup[n][q + 1]};
                            gl.x = fminf(gl.x, 7.f); gl.y = fminf(gl.y, 7.f); up.x = fminf(fmaxf(up.x, -7.f), 7.f); up.y = fminf(fmaxf(up.y, -7.f), 7.f);
                            const f2 ar = gl * (-1.702f * 1.44269504089f); f2 dn; dn.x = __builtin_amdgcn_exp2f(ar.x); dn.y = __builtin_amdgcn_exp2f(ar.y); dn = dn + 1.f;
                            f2 rc; rc.x = __builtin_amdgcn_rcpf(dn.x); rc.y = __builtin_amdgcn_rcpf(dn.y);
                            const f2 hh = (up * HID_SCALE + HID_SCALE) * gl * rc; hv[4 * n + q] = hh.x; hv[4 * n + q + 1] = hh.y; }
                    w[t].x = (unsigned)__builtin_amdgcn_cvt_pk_fp8_f32(hv[0], hv[1], 0, false); w[t].x = (unsigned)__builtin_amdgcn_cvt_pk_fp8_f32(hv[2], hv[3], (int)w[t].x, true);
                    w[t].y = (unsigned)__builtin_amdgcn_cvt_pk_fp8_f32(hv[4], hv[5], 0, false); w[t].y = (unsigned)__builtin_amdgcn_cvt_pk_fp8_f32(hv[6], hv[7], (int)w[t].y, true); }
                const u32x2 send = odd ? w[0] : w[1], keep = odd ? w[1] : w[0];
                u32x2 recv; recv.x = (unsigned)__shfl_xor((int)send.x, 16); recv.y = (unsigned)__shfl_xor((int)send.y, 16);
                const u32x4 o = odd ? (u32x4){recv.x, recv.y, keep.x, keep.y} : (u32x4){keep.x, keep.y, recv.x, recv.y};
                *(u32x4*)((unsigned char*)HID + (size_t)(row0 + ai * HALF + (2 * mp + odd) * 16) * FF + (j0 - 8 * odd)) = o; }
    }
};
struct EpiO {
    static constexpr bool PERM = true; unsigned char* O8; const float* bdn;
    struct Pre { f32x4 bv[2][2]; };
    __device__ __forceinline__ void prefetch(Pre& p, const GU& u, int wr, int wc, int fr, int fq) const {
        const float* bp = bdn + (size_t)u.e * D + u.pn * BM + wc * 32 + 8 * fq;
#pragma unroll
        for (int bj = 0; bj < 2; ++bj)
#pragma unroll
            for (int n = 0; n < 2; ++n) p.bv[bj][n] = *(const f32x4*)(bp + bj * HALF + 4 * n);
    }
    __device__ __forceinline__ void operator()(const f32x4 (&acc)[2][2][4][2], const GU& u, int wr, int wc, int fr, int fq, const Pre& pre) const {
        const int r0 = wr * 64 + fr, col0 = u.pn * BM + wc * 32 + 8 * fq, odd = fq & 1;
        f32x4 bv[2][2];
#pragma unroll
        for (int bj = 0; bj < 2; ++bj)
#pragma unroll
            for (int n = 0; n < 2; ++n) bv[bj][n] = pre.bv[bj][n] * O8_SCALE;
        constexpr float sc = O8_SCALE / (W8_SCALE * HID_SCALE);
#pragma unroll
        for (int ai = 0; ai < 2; ++ai)
#pragma unroll
            for (int mp = 0; mp < 2; ++mp) {
                const int r = r0 + ai * HALF + (2 * mp + odd) * 16;
                const bool ok = r < u.nvalid; const int slot = ok ? u.tab[r] : 0;
                unsigned char* rowp = O8 + (size_t)slot * D + (col0 - 8 * odd);
#pragma unroll
                for (int bj = 0; bj < 2; ++bj) {
                    u32x2 w[2];
#pragma unroll
                    for (int q = 0; q < 2; ++q) { const f32x4 v0 = acc[ai][bj][2 * mp + q][0] * sc + bv[bj][0], v1 = acc[ai][bj][2 * mp + q][1] * sc + bv[bj][1];
                        w[q].x = (unsigned)__builtin_amdgcn_cvt_pk_fp8_f32(v0[0], v0[1], 0, false); w[q].x = (unsigned)__builtin_amdgcn_cvt_pk_fp8_f32(v0[2], v0[3], (int)w[q].x, true);
                        w[q].y = (unsigned)__builtin_amdgcn_cvt_pk_fp8_f32(v1[0], v1[1], 0, false); w[q].y = (unsigned)__builtin_amdgcn_cvt_pk_fp8_f32(v1[2], v1[3], (int)w[q].y, true); }
                    const u32x2 send = odd ? w[0] : w[1], keep = odd ? w[1] : w[0];
                    u32x2 recv; recv.x = (unsigned)__shfl_xor((int)send.x, 16); recv.y = (unsigned)__shfl_xor((int)send.y, 16);
                    const u32x4 o = odd ? (u32x4){recv.x, recv.y, keep.x, keep.y} : (u32x4){keep.x, keep.y, recv.x, recv.y};
                    if (ok) *(u32x4*)(rowp + bj * HALF) = o;
                }
            }
    }
};
}


#define XB_TMO      128
#define XB_XCNT(j)  (256  + 64 * (j))
#define XB_XSUB(j)  (1280 + 64 * (j))
#define XB_XGEN(j)  (2304 + 64 * (j))
#define XB_TOP      3328
#define XB_TOPGEN   3392
#define XCD_BAR_WORDS 3456
#define XB_SPIN_CAP (1u << 18)

__device__ __forceinline__ unsigned xb_ld(unsigned* p)              { return __hip_atomic_load(p, __ATOMIC_RELAXED, __HIP_MEMORY_SCOPE_AGENT); }
__device__ __forceinline__ unsigned xb_add(unsigned* p, unsigned v) { return __hip_atomic_fetch_add(p, v, __ATOMIC_RELAXED, __HIP_MEMORY_SCOPE_AGENT); }
__device__ __forceinline__ unsigned xb_xcc_id() { return (unsigned)__builtin_amdgcn_s_getreg((3 << 11) | 20) & 0xFu; }
#define XB_SPIN(cond, bar) do { unsigned _sp = 0; while (cond) { __builtin_amdgcn_s_sleep(1); \
    if ((++_sp & 255u) == 0u) { if (xb_ld(&(bar)[XB_TMO])) break; if (_sp > XB_SPIN_CAP) { atomicAdd(&(bar)[XB_TMO], 1u); break; } } } } while (0)

struct XcdBarrier {
    unsigned* bar; unsigned x; unsigned gsize; unsigned w;
    volatile LAS unsigned* st;
};

__device__ __forceinline__ XcdBarrier xcd_barrier_post(unsigned* bar, volatile LAS unsigned* st, unsigned gsize, unsigned w) {
    XcdBarrier b; b.bar = bar; b.x = xb_xcc_id(); b.st = st; b.gsize = gsize; b.w = w;
    if (b.w == 0u && mk_lane() == 0) (void)xb_add(&bar[XB_XCNT(b.x)], 1u);
    return b;
}
__device__ __forceinline__ void xcd_barrier_complete(unsigned* bar, unsigned x, unsigned& nloc, unsigned& nx, unsigned G) {
    unsigned sum, cnt, mine, sp = 0u;
    for (;;) {
        sum = 0u; cnt = 0u; mine = 0u;
#pragma unroll
        for (unsigned j = 0; j < 16; ++j) { const unsigned c = xb_ld(&bar[XB_XCNT(j)]); sum += c; cnt += (c > 0u) ? 1u : 0u; mine = (j == x) ? c : mine; }
        if (sum == G) break;
        __builtin_amdgcn_s_sleep(1);
        if ((++sp & 255u) == 0u) { if (xb_ld(&bar[XB_TMO])) break; if (sp > XB_SPIN_CAP) { atomicAdd(&bar[XB_TMO], 1u); break; } }
    }
    nloc = mine > 0u ? mine : 1u; nx = cnt > 0u ? cnt : 1u;
}

__device__ __forceinline__ void xcd_barrier(const XcdBarrier& b) {
    asm volatile("s_waitcnt vmcnt(0)" ::: "memory");
    __syncthreads();
    if (b.w == 0u && mk_lane() == 0) {
        unsigned* bar = b.bar;
        __builtin_amdgcn_s_waitcnt(0);
        unsigned nloc = b.st[0], nx = b.st[1];
        if (nloc == 0u) { xcd_barrier_complete(bar, b.x, nloc, nx, b.gsize); b.st[0] = nloc; b.st[1] = nx; }
        const unsigned old = xb_add(&bar[XB_XSUB(b.x)], 1u);
        const unsigned gen = old / nloc;
        if (old + 1u == (gen + 1u) * nloc) {
            __builtin_amdgcn_fence(__ATOMIC_RELEASE, "agent");
            asm volatile("s_waitcnt vmcnt(0)" ::: "memory");
            const unsigned og = xb_add(&bar[XB_TOP], 1u);
            const unsigned tg = og / nx;
            if (og + 1u == (tg + 1u) * nx) xb_add(&bar[XB_TOPGEN], 1u);
            else XB_SPIN(xb_ld(&bar[XB_TOPGEN]) == tg, bar);
            __builtin_amdgcn_fence(__ATOMIC_ACQUIRE, "agent");
            xb_add(&bar[XB_XGEN(b.x)], 1u);
            asm volatile("s_waitcnt vmcnt(0)" ::: "memory");
        } else {
            XB_SPIN(xb_ld(&bar[XB_XGEN(b.x)]) == gen, bar);
            __builtin_amdgcn_fence(__ATOMIC_ACQUIRE, "agent");
            asm volatile("s_waitcnt vmcnt(0)" ::: "memory");
        }
    }
    __syncthreads();
}

constexpr int LDS_STAGE = 131072, LDS_MISC = 135168, LDS_BYTES = 147456;
struct Args { const float* in[31]; float* out; unsigned char* ws; int ph_lo, ph_hi; };

template <int MAP> __device__ __forceinline__ int map_col(int n) {
    if (MAP == 0) return n;
    const int up = n >= FF ? 1 : 0, j = n - up * FF; return (j >> 7) * 256 + up * 128 + (j & 127);
}
__device__ __forceinline__ int map_win(int n) { const int g = n >> 8, c = n & 255;
    if (g == 5 || g == 6) return (5 + (c >> 7)) * 256 + (g - 5) * 128 + (c & 127);
    if (g == 8 || g == 9) return (8 + (c >> 7)) * 256 + (g - 8) * 128 + (c & 127);
    return n; }
struct TItem { const float* W; bf16* WT; int K, N, k0, n0, r0, f8; };
__device__ __forceinline__ bool t_decode(long it, int part, const float* w_in, const float* w_out, const float* w_gu, const float* w_dn, bf16* WIN, bf16* WOUT, bf16* WGU, bf16* WDN, unsigned char* WINQ, TItem& t) {
    constexpr int NB_IN = (G1_QLO == 0) ? (DIN - G1_QHI * 256) / 32 : DIN / 32;
    constexpr int I_IN = (D / 128) * NB_IN, I_OUT = (D / 128) * (D / 32), I_GU = (D / 128) * (2 * FF / 32), I_DN = (FF / 128) * (D / 32);
    constexpr long T_IN = (long)NL * I_IN, T_OUT = (long)NL * I_OUT, T_GU = (long)NL * NE * I_GU, T_DN = (long)NL * NE * I_DN;
    if (part == 0) return false;
    if (part == 3) { if (it >= T_IN + T_OUT) {
            constexpr int I_INQ = (D / 128) * (DINQ / 32); it -= T_IN + T_OUT; if (DINQ == 0 || it >= (long)NL * I_INQ) return false;
            const int m = (int)(it / I_INQ), i = (int)(it % I_INQ), nblk = DINQ / 32, kb = i / nblk, nb = i % nblk;
            t.W = w_in + (size_t)m * D * DIN; t.WT = (bf16*)(WINQ + (size_t)m * DINQ * D); t.K = D; t.N = DIN; t.f8 = 1; t.k0 = 128 * kb; t.n0 = G1_QLO * 256 + 32 * nb; t.r0 = map_win(t.n0) - G1_QLO * 256;
            return true; } }
    else { const int l = part - 1; if (it >= (long)NE * (I_GU + I_DN)) return false; it = it < (long)NE * I_GU ? T_IN + T_OUT + (long)l * NE * I_GU + it : T_IN + T_OUT + T_GU + (long)l * NE * I_DN + (it - (long)NE * I_GU); }
    if (it >= T_IN + T_OUT + T_GU + T_DN) return false;
    int m, i, map = 0;
    if (it < T_IN) { m = (int)(it / I_IN); i = (int)(it % I_IN); t.W = w_in + (size_t)m * D * DIN; t.WT = G1_FP8 ? (bf16*)((unsigned char*)WIN + (size_t)m * DIN * D) : WIN + (size_t)m * DIN * D; t.K = D; t.N = DIN; t.f8 = G1_FP8; map = 2; }
    else if (it < T_IN + T_OUT) { it -= T_IN; m = (int)(it / I_OUT); i = (int)(it % I_OUT); t.W = w_out + (size_t)m * D * D; t.WT = WOUT + (size_t)m * D * D; t.K = D; t.N = D; t.f8 = 0; }
    else if (it < T_IN + T_OUT + T_GU) { it -= T_IN + T_OUT; m = (int)(it / I_GU); i = (int)(it % I_GU); t.W = w_gu + (size_t)m * D * 2 * FF; t.WT = (bf16*)((unsigned char*)WGU + (size_t)m * 2 * FF * D); t.K = D; t.N = 2 * FF; map = 1; t.f8 = 1; }
    else { it -= T_IN + T_OUT + T_GU; m = (int)(it / I_DN); i = (int)(it % I_DN); t.W = w_dn + (size_t)m * FF * D; t.WT = (bf16*)((unsigned char*)WDN + (size_t)m * D * FF); t.K = FF; t.N = D; t.f8 = 1; }
    const int nblk = map == 2 ? NB_IN : t.N / 32, kb = i / nblk, nb = i % nblk; t.k0 = 128 * kb; t.n0 = (map == 2 ? DIN - NB_IN * 32 : 0) + 32 * nb; t.r0 = map == 1 ? map_col<1>(t.n0) : (map == 2 ? map_win(t.n0) : t.n0);
    return true;
}
__device__ __forceinline__ void t_load(const TItem& t, int lane, f32x4 (&v)[16]) {
#pragma unroll
    for (int i = 0; i < 16; ++i) { const int kk = 8 * i + (lane >> 3); v[i] = __builtin_nontemporal_load((const f32x4*)(t.W + (size_t)(t.k0 + kk) * t.N + t.n0 + 4 * (lane & 7))); }
}
__device__ __forceinline__ void t_store(const TItem& t, int lane, const f32x4 (&v)[16], LAS float* scr) {
#pragma unroll
    for (int i = 0; i < 16; ++i) { const int kk = 8 * i + (lane >> 3); LAS float* p = scr + kk * 33 + 4 * (lane & 7); p[0] = v[i].x; p[1] = v[i].y; p[2] = v[i].z; p[3] = v[i].w; }
    LDS_WAIT();
    const int n = lane >> 1, hh = lane & 1; const LAS float* s = scr + (64 * hh) * 33 + n;
    if (t.f8) {
        unsigned w[16];
#pragma unroll
        for (int q = 0; q < 16; ++q) { int x = __builtin_amdgcn_cvt_pk_fp8_f32(s[(4 * q) * 33] * pg8::W8_SCALE, s[(4 * q + 1) * 33] * pg8::W8_SCALE, 0, false);
            x = __builtin_amdgcn_cvt_pk_fp8_f32(s[(4 * q + 2) * 33] * pg8::W8_SCALE, s[(4 * q + 3) * 33] * pg8::W8_SCALE, x, true); w[q] = (unsigned)x; }
        unsigned char* dst = (unsigned char*)t.WT + (size_t)(t.r0 + n) * t.K + t.k0 + 64 * hh;
#pragma unroll
        for (int q = 0; q < 4; ++q) *(u32x4*)(dst + 16 * q) = (u32x4){w[4 * q], w[4 * q + 1], w[4 * q + 2], w[4 * q + 3]};
    } else {
        bf16* dst = t.WT + (size_t)(t.r0 + n) * t.K + t.k0 + 64 * hh;
#pragma unroll
        for (int q = 0; q < 8; ++q) { u32x4 o; o.x = pk2(s[(8 * q) * 33], s[(8 * q + 1) * 33]); o.y = pk2(s[(8 * q + 2) * 33], s[(8 * q + 3) * 33]); o.z = pk2(s[(8 * q + 4) * 33], s[(8 * q + 5) * 33]); o.w = pk2(s[(8 * q + 6) * 33], s[(8 * q + 7) * 33]);
            *(u32x4*)(dst + 8 * q) = o; }
    }
    LDS_WAIT();
}
__device__ __forceinline__ void ph_prologue(LAS unsigned char* lds, const Args& a, const Grp grp, int part, long it_lo = 0, long it_hi = (1L << 40)) {
    int tid_ = MK_TID(grp); asm volatile("" : "+v"(tid_)); const int tid = tid_, wave = tid >> 6, lane = tid & 63, G = grp.n, vcu = grp.v;
    const float* c = a.in[1]; const float* c_ctx = a.in[3]; const float* w_mod = a.in[4]; const float* b_mod = a.in[5];
    float* mod = (float*)(a.ws + WS_MOD);
    if (part == 0) { LAS float* sc = (LAS float*)lds; LAS float* part_ = sc + 17 * D;
      for (int it = vcu; it < NL * (MODW / 64); it += G) {
        const int l = it / (MODW / 64), cb = it % (MODW / 64), col = tid & 63, w = tid >> 6;
        __syncthreads();
        for (int idx = tid; idx < 17 * D; idx += 512) { const int r = idx >> 10, k = idx & 1023; sc[idx] = silu_f(r < 16 ? c[r * D + k] : c_ctx[k]); }
        __syncthreads();
        float acc[17];
#pragma unroll
        for (int r = 0; r < 17; ++r) acc[r] = 0.f;
        const float* wp = w_mod + ((size_t)l * D + 128 * w) * MODW + cb * 64 + col;
#pragma unroll 4
        for (int kk = 0; kk < 128; kk += 4) {
            const float w0 = wp[(size_t)kk * MODW], w1 = wp[(size_t)(kk + 1) * MODW], w2 = wp[(size_t)(kk + 2) * MODW], w3 = wp[(size_t)(kk + 3) * MODW];
#pragma unroll
            for (int r = 0; r < 17; ++r) { const f32x4 s = *(const LAS f32x4*)(sc + r * D + 128 * w + kk); acc[r] += s.x * w0 + s.y * w1 + s.z * w2 + s.w * w3; }
        }
#pragma unroll
        for (int r = 0; r < 17; ++r) part_[(w * 17 + r) * 64 + col] = acc[r];
        __syncthreads();
        for (int idx = tid; idx < 17 * 64; idx += 512) { const int r = idx >> 6, cc = idx & 63; float s = 0.f;
#pragma unroll
            for (int ww = 0; ww < 8; ++ww) s += part_[(ww * 17 + r) * 64 + cc];
            mod[((size_t)l * 17 + r) * MODW + cb * 64 + cc] = s + b_mod[l * MODW + cb * 64 + cc]; }
      }
      __syncthreads(); }
    if (part == 0) { unsigned char* rwt = a.ws + WS_RWT;
      for (int idx = vcu * 512 + tid; idx < NL * D * NE; idx += G * 512) { const int l = idx / (D * NE), r = idx % (D * NE), k = r >> 5, e = r & 31; const float w = a.in[25][idx];
          const bf16 hi = f2bf(w), lo = f2bf(w - bf2f(hi)); bf16* dst = (bf16*)(rwt + (size_t)l * (2 * 32 * 2064) + (size_t)e * 2064) + k; dst[0] = hi; *(bf16*)((unsigned char*)dst + 32 * 2064) = lo; } }
    __syncthreads();
    LAS float* scr = (LAS float*)(lds + wave * 16896);
    bf16* WIN = (bf16*)(a.ws + WS_WIN); bf16* WOUT = (bf16*)(a.ws + WS_WOUT); bf16* WGU = (bf16*)(a.ws + WS_WGU); bf16* WDN = (bf16*)(a.ws + WS_WDN);
    const long gw = (long)vcu * 8 + wave, ngw = (long)G * 8;
    TItem cur, nxt; f32x4 vc[16], vn[16];
    long it = it_lo + gw; bool have = it < it_hi && t_decode(it, part, a.in[8], a.in[24], a.in[27], a.in[29], WIN, WOUT, WGU, WDN, a.ws + WS_WINQ, cur);
    if (have) t_load(cur, lane, vc);
    while (have) {
        it += ngw; const bool hn = it < it_hi && t_decode(it, part, a.in[8], a.in[24], a.in[27], a.in[29], WIN, WOUT, WGU, WDN, a.ws + WS_WINQ, nxt);
        if (hn) t_load(nxt, lane, vn);
        t_store(cur, lane, vc, scr);
        cur = nxt; have = hn;
#pragma unroll
        for (int i = 0; i < 16; ++i) vc[i] = vn[i];
    }
}

struct RowIn { u32x4 ow[4]; u32x4 xw[2]; f32x4 gt; };
struct Coef { f32x4 a[4], b[4], g2[4]; };
__device__ __forceinline__ void row_load(RowIn& r, bool from_input, const float* src_f32, const bf16* X, const unsigned char* O8, const float* gate, int tok, int lane) {
    if (from_input) {
#pragma unroll
        for (int q = 0; q < 4; ++q) r.ow[q] = *(const u32x4*)(src_f32 + 16 * lane + 4 * q);
    } else {
        r.xw[0] = *(const u32x4*)(X + (size_t)tok * D + 16 * lane); r.xw[1] = *(const u32x4*)(X + (size_t)tok * D + 16 * lane + 8);
#pragma unroll
        for (int k = 0; k < 4; ++k) r.ow[k] = *(const u32x4*)(O8 + (size_t)(tok * 4 + k) * D + 16 * lane);
        r.gt = *(const f32x4*)(gate + (size_t)tok * 4);
    }
}
__device__ __forceinline__ void coef_load(Coef& c, int l, int mr, int lane, const float* mod, const float* norm_g, bool with_norm) {
    if (with_norm) { const float* mrow = mod + ((size_t)l * 17 + mr) * MODW + 16 * lane;
#pragma unroll
        for (int q = 0; q < 4; ++q) { const f32x4 g = *(const f32x4*)(norm_g + 16 * lane + 4 * q), sh = *(const f32x4*)(mrow + 4 * q), sc = *(const f32x4*)(mrow + D + 4 * q); c.a[q] = g * (1.f + sc); c.b[q] = sh; } }
    if (l > 0) {
#pragma unroll
        for (int q = 0; q < 4; ++q) c.g2[q] = *(const f32x4*)(mod + ((size_t)(l - 1) * 17 + mr) * MODW + 5 * D + 16 * lane + 4 * q); }
}
__device__ __forceinline__ void combine16(const RowIn& r, const Coef& c, float (&v)[16]) {
    float s[16];
#pragma unroll
    for (int i = 0; i < 16; ++i) s[i] = 0.f;
#pragma unroll
    for (int k = 0; k < 4; ++k) { const float gk = r.gt[k] * (1.f / pg8::O8_SCALE);
#pragma unroll
        for (int q = 0; q < 4; ++q) { const f32x2 lo = __builtin_amdgcn_cvt_pk_f32_fp8((int)r.ow[k][q], false), hi = __builtin_amdgcn_cvt_pk_f32_fp8((int)r.ow[k][q], true);
            s[4 * q] += gk * lo.x; s[4 * q + 1] += gk * lo.y; s[4 * q + 2] += gk * hi.x; s[4 * q + 3] += gk * hi.y; } }
#pragma unroll
    for (int q = 0; q < 4; ++q) { const f32x4 g2 = c.g2[q]; const unsigned w0 = r.xw[q >> 1][(q & 1) * 2], w1 = r.xw[q >> 1][(q & 1) * 2 + 1];
        v[4 * q] = blo(w0) + g2.x * s[4 * q]; v[4 * q + 1] = bhi(w0) + g2.y * s[4 * q + 1]; v[4 * q + 2] = blo(w1) + g2.z * s[4 * q + 2]; v[4 * q + 3] = bhi(w1) + g2.w * s[4 * q + 3]; }
}
__device__ __forceinline__ void norm1_row(const RowIn& r, const Coef& c, int l, int tok, int lane, bf16* Xd, bf16* H, unsigned char* HQ) {
    float v[16];
    if (l == 0) {
#pragma unroll
        for (int q = 0; q < 4; ++q) { v[4 * q] = __uint_as_float(r.ow[q].x); v[4 * q + 1] = __uint_as_float(r.ow[q].y); v[4 * q + 2] = __uint_as_float(r.ow[q].z); v[4 * q + 3] = __uint_as_float(r.ow[q].w); }
    } else {
        combine16(r, c, v);
        u32x4 o0, o1; o0.x = pk2(v[0], v[1]); o0.y = pk2(v[2], v[3]); o0.z = pk2(v[4], v[5]); o0.w = pk2(v[6], v[7]); o1.x = pk2(v[8], v[9]); o1.y = pk2(v[10], v[11]); o1.z = pk2(v[12], v[13]); o1.w = pk2(v[14], v[15]);
        *(u32x4*)(Xd + (size_t)tok * D + 16 * lane) = o0; *(u32x4*)(Xd + (size_t)tok * D + 16 * lane + 8) = o1;
    }
    float ss = 0.f;
#pragma unroll
    for (int i = 0; i < 16; ++i) ss += v[i] * v[i];
    const float rstd = rsqrtf(wave_sum(ss) * (1.f / D) + EPS);
    unsigned hw[8];
#pragma unroll
    for (int q = 0; q < 4; ++q) { const f32x4 ca = c.a[q], cb = c.b[q];
        hw[2 * q] = pk2(v[4 * q] * rstd * ca.x + cb.x, v[4 * q + 1] * rstd * ca.y + cb.y); hw[2 * q + 1] = pk2(v[4 * q + 2] * rstd * ca.z + cb.z, v[4 * q + 3] * rstd * ca.w + cb.w); }
    *(u32x4*)(H + (size_t)tok * D + 16 * lane) = (u32x4){hw[0], hw[1], hw[2], hw[3]}; *(u32x4*)(H + (size_t)tok * D + 16 * lane + 8) = (u32x4){hw[4], hw[5], hw[6], hw[7]};
    if (DINQ > 0) { u32x4 w8;
#pragma unroll
        for (int q = 0; q < 4; ++q) { int t8 = __builtin_amdgcn_cvt_pk_fp8_f32(blo(hw[2 * q]), bhi(hw[2 * q]), 0, false); t8 = __builtin_amdgcn_cvt_pk_fp8_f32(blo(hw[2 * q + 1]), bhi(hw[2 * q + 1]), t8, true); w8[q] = (unsigned)t8; }
        *(u32x4*)(HQ + (size_t)tok * D + 16 * lane) = w8; }
}
__device__ __forceinline__ void ph_norm1(int l, const Args& a, const Grp grp) {
    int tid_ = MK_TID(grp); asm volatile("" : "+v"(tid_)); const int tid = tid_, lane = tid & 63, gw = grp.v * 8 + __builtin_amdgcn_readfirstlane(tid >> 6), ngw = grp.n * 8;
    const float* xin = a.in[0]; const float* ctxin = a.in[2]; const float* norm_g = a.in[6] + l * D;
    const bf16* X = (const bf16*)(a.ws + WS_X); bf16* Xd = (bf16*)(a.ws + WS_X); const unsigned char* O8 = a.ws + WS_O; const float* gate = (const float*)(a.ws + WS_GATE); const float* mod = (const float*)(a.ws + WS_MOD); bf16* H = (bf16*)(a.ws + WS_H); unsigned char* HQ = a.ws + WS_HQ;
    const int rpw = (GTOK + ngw - 1) / ngw, t0 = gw * rpw, t1 = (t0 + rpw < GTOK) ? t0 + rpw : GTOK;
    if (t0 >= t1) return;
    Coef c; int cmr = -1;
    RowIn ra, rb, rc;
#define N1_LOAD(r, t) do { const int _tk = gtok(grp.g, (t) < t1 ? (t) : t1 - 1); row_load(r, l == 0, _tk < NLAT ? xin + (size_t)_tk * D : ctxin + (size_t)(_tk - NLAT) * D, X, O8, gate, _tk, lane); } while (0)
#define N1_ROW(r, t) do { if ((t) < t1) { const int _tk = gtok(grp.g, (t)), _mr = tok_modrow(_tk); if (_mr != cmr) { cmr = _mr; coef_load(c, l, _mr, lane, mod, norm_g, true); } norm1_row(r, c, l, _tk, lane, Xd, H, HQ); } } while (0)
    N1_LOAD(ra, t0); N1_LOAD(rb, t0 + 1);
    for (int t = t0; t < t1; t += 3) {
        N1_LOAD(rc, t + 2); N1_ROW(ra, t);
        N1_LOAD(ra, t + 3); N1_ROW(rb, t + 1);
        N1_LOAD(rb, t + 4); N1_ROW(rc, t + 2);
    }
#undef N1_LOAD
#undef N1_ROW
}
__device__ __forceinline__ void ph_final(const Args& a, const Grp grp) {
    int tid_ = MK_TID(grp); asm volatile("" : "+v"(tid_)); const int tid = tid_, lane = tid & 63, gw = grp.v * 8 + __builtin_amdgcn_readfirstlane(tid >> 6), ngw = grp.n * 8;
    const bf16* X = (const bf16*)(a.ws + WS_X); const unsigned char* O8 = a.ws + WS_O; const float* gate = (const float*)(a.ws + WS_GATE); const float* mod = (const float*)(a.ws + WS_MOD);
    const int rpw = (GLAT + ngw - 1) / ngw, t0 = gw * rpw, t1 = (t0 + rpw < GLAT) ? t0 + rpw : GLAT;
    if (t0 >= t1) return;
    Coef c; int cmr = -1;
    RowIn ra, rb, rc;
#define FN_LOAD(r, t) row_load(r, false, nullptr, X, O8, gate, grp.g * GLAT + ((t) < t1 ? (t) : t1 - 1), lane)
#define FN_ROW(r, t) do { if ((t) < t1) { const int _tk = grp.g * GLAT + (t), _mr = tok_modrow(_tk); if (_mr != cmr) { cmr = _mr; coef_load(c, NL, _mr, lane, mod, nullptr, false); } float v[16]; combine16(r, c, v); \
        _Pragma("unroll") for (int q = 0; q < 4; ++q) *(f32x4*)(a.out + (size_t)_tk * D + 16 * lane + 4 * q) = (f32x4){v[4 * q], v[4 * q + 1], v[4 * q + 2], v[4 * q + 3]}; } } while (0)
    FN_LOAD(ra, t0); FN_LOAD(rb, t0 + 1);
    for (int t = t0; t < t1; t += 3) {
        FN_LOAD(rc, t + 2); FN_ROW(ra, t);
        FN_LOAD(ra, t + 3); FN_ROW(rb, t + 1);
        FN_LOAD(rb, t + 4); FN_ROW(rc, t + 2);
    }
#undef FN_LOAD
#undef FN_ROW
}

__device__ __forceinline__ void ph_prep(int l, const Args& a, const Grp grp) {
    int tid_ = MK_TID(grp); asm volatile("" : "+v"(tid_)); const int tid = tid_, lane = tid & 63, G = grp.n, vcu = grp.v;
    bf16* P = (bf16*)(a.ws + WS_P); bf16* VT = (bf16*)(a.ws + WS_VT);
    const float* qg = a.in[12]; const float* kg = a.in[13];
    const int gw = vcu * 8 + (tid >> 6), ngw = G * 8;
    for (int it = gw; it < (GTOK / 64) * 4; it += ngw) {
        const int h = it & 3, tok0 = gtok(grp.g, (it >> 2) * 64), tok = tok0 + lane;
        int b, key0; if (tok < NLAT) { b = tok >> 11; key0 = tok0 & 2047; } else { b = (tok - NLAT) >> 8; key0 = 2048 + ((tok0 - NLAT) & 255); }
        const int g = lane >> 5, k32 = lane & 31, pos = g * 32 + ((k32 & 15) >> 2) * 8 + (k32 >> 4) * 4 + (k32 & 3);
        const bf16* vp = P + (size_t)tok * DINP + 1024 + h * 64;
        bf16* dst = VT + ((size_t)(b * 4 + h) * 64) * NKEY + key0 + pos;
#pragma unroll
        for (int q = 0; q < 8; ++q) { const u32x4 w = *(const u32x4*)(vp + 8 * q);
            dst[(size_t)(8 * q + 0) * NKEY] = (bf16)(w.x & 0xffffu); dst[(size_t)(8 * q + 1) * NKEY] = (bf16)(w.x >> 16); dst[(size_t)(8 * q + 2) * NKEY] = (bf16)(w.y & 0xffffu); dst[(size_t)(8 * q + 3) * NKEY] = (bf16)(w.y >> 16);
            dst[(size_t)(8 * q + 4) * NKEY] = (bf16)(w.z & 0xffffu); dst[(size_t)(8 * q + 5) * NKEY] = (bf16)(w.z >> 16); dst[(size_t)(8 * q + 6) * NKEY] = (bf16)(w.w & 0xffffu); dst[(size_t)(8 * q + 7) * NKEY] = (bf16)(w.w >> 16); }
    }
}
__device__ __forceinline__ void ph_mix_a(LAS unsigned char* lds, int l, int ntok, const Args& a, const Grp grp) {
    int tid_ = MK_TID(grp); asm volatile("" : "+v"(tid_)); const int tid = tid_, wave = __builtin_amdgcn_readfirstlane(tid >> 6), lane = tid & 63, fr = lane & 15, fq = lane >> 4, G = grp.n, vcu = grp.v;
    const bf16* P = (const bf16*)(a.ws + WS_P); bf16* Y = (bf16*)(a.ws + WS_Y);
    const float* vg = a.in[9] + l * 256; const float* aws = a.in[10] + (size_t)l * 4 * 128 * 128; const float* abs_ = a.in[11] + l * 4 * 128;
    constexpr int VPITCH = 272;
    const int nit = (ntok / 128) * 4;
    const int q = tid >> 2, part = tid & 3, p = wave * 16 + fr;
    int hcur = -1; float vgr[16]; bf16x8_t wf[4]; float bs = 0.f;
    u32x4 w0, w1, n0, n1;
#define MA_LOADV(x0, x1, it) do { const bf16* _vp = P + (size_t)(gtok(grp.g, ((it) >> 2) * 128) + q) * DINP + 256 + ((it) & 3) * 64 + part * 16; x0 = *(const u32x4*)_vp; x1 = *(const u32x4*)(_vp + 8); } while (0)
    if (vcu < nit) MA_LOADV(w0, w1, vcu);
    for (int it = vcu; it < nit; it += G) {
        const int h = it & 3, tokbase = gtok(grp.g, (it >> 2) * 128), tok = tokbase + p;
        u32x2 uw[4];
#pragma unroll
        for (int cb = 0; cb < 4; ++cb) uw[cb] = *(const u32x2*)(P + (size_t)tok * DINP + h * 64 + 16 * cb + 4 * fq);
        if (h != hcur) { hcur = h;
#pragma unroll
            for (int i = 0; i < 16; ++i) vgr[i] = vg[h * 64 + part * 16 + i];
            const float* wrow = aws + ((size_t)h * 128 + p) * 128;
#pragma unroll
            for (int ks = 0; ks < 4; ++ks) { const f32x4 wa = *(const f32x4*)(wrow + 32 * ks + 8 * fq), wb = *(const f32x4*)(wrow + 32 * ks + 8 * fq + 4);
                u32x4 wp; wp.x = pk2(wa.x, wa.y); wp.y = pk2(wa.z, wa.w); wp.z = pk2(wb.x, wb.y); wp.w = pk2(wb.z, wb.w); wf[ks] = __builtin_bit_cast(bf16x8_t, wp); }
            bs = abs_[h * 128 + p]; }
        __syncthreads();
        {
            float v[16] = {blo(w0.x), bhi(w0.x), blo(w0.y), bhi(w0.y), blo(w0.z), bhi(w0.z), blo(w0.w), bhi(w0.w), blo(w1.x), bhi(w1.x), blo(w1.y), bhi(w1.y), blo(w1.z), bhi(w1.z), blo(w1.w), bhi(w1.w)};
            float ss = 0.f;
#pragma unroll
            for (int i = 0; i < 16; ++i) { v[i] = gelu_tanh(v[i]); ss += v[i] * v[i]; }
            ss += __shfl_xor(ss, 1); ss += __shfl_xor(ss, 2);
            const float rstd = rsqrtf(ss * (1.f / 64.f) + EPS);
#pragma unroll
            for (int i = 0; i < 16; ++i) { const int c = part * 16 + i; *(LAS bf16*)(lds + c * VPITCH + q * 2) = f2bf(v[i] * rstd * vgr[i]); }
        }
        __syncthreads();
        if (it + G < nit) MA_LOADV(n0, n1, it + G);
        {
            f32x4 acc[4];
#pragma unroll
            for (int cb = 0; cb < 4; ++cb) acc[cb] = (f32x4){0.f, 0.f, 0.f, 0.f};
#pragma unroll
            for (int ks = 0; ks < 4; ++ks) {
#pragma unroll
                for (int cb = 0; cb < 4; ++cb) {
                    const bf16x8_t vf = *(const LAS bf16x8_t*)(lds + (16 * cb + fr) * VPITCH + (32 * ks + 8 * fq) * 2);
                    acc[cb] = __builtin_amdgcn_mfma_f32_16x16x32_bf16(vf, wf[ks], acc[cb], 0, 0, 0);
                }
            }
#pragma unroll
            for (int cb = 0; cb < 4; ++cb) {
                const int c = h * 64 + 16 * cb + 4 * fq;
                u32x2 o; o.x = pk2(gelu_tanh(blo(uw[cb].x)) * (acc[cb][0] + bs), gelu_tanh(bhi(uw[cb].x)) * (acc[cb][1] + bs)); o.y = pk2(gelu_tanh(blo(uw[cb].y)) * (acc[cb][2] + bs), gelu_tanh(bhi(uw[cb].y)) * (acc[cb][3] + bs));
                *(u32x2*)(Y + (size_t)tok * D + c) = o;
            }
        }
        w0 = n0; w1 = n1;
    }
#undef MA_LOADV
    __syncthreads();
}

__device__ __forceinline__ void ph_mix_c(LAS unsigned char* lds, int l, int ntok, const Args& a, const Grp grp) {
    int tid_ = MK_TID(grp); asm volatile("" : "+v"(tid_)); const int tid = tid_, wave = __builtin_amdgcn_readfirstlane(tid >> 6), lane = tid & 63, G = grp.n, vcu = grp.v;
    const bf16* P = (const bf16*)(a.ws + WS_P); bf16* Y = (bf16*)(a.ws + WS_Y);
    const float* cw = a.in[19] + l * 31 * 256; const float* cb = a.in[20] + l * 256; const float* lg = a.in[21] + l * 256; const float* lb = a.in[22] + l * 256;
    LAS float* zs = (LAS float*)lds;
    LAS float* wl = (LAS float*)(lds + 96256);
    __syncthreads();
    for (int i = tid; i < 31 * 256; i += 512) wl[i] = cw[i];
    float gv[4], bv[4], cbv[4];
#pragma unroll
    for (int hp = 0; hp < 2; ++hp)
#pragma unroll
        for (int e = 0; e < 2; ++e) { const int c = hp * 128 + 2 * lane + e; gv[2 * hp + e] = lg[c]; bv[2 * hp + e] = lb[c]; cbv[2 * hp + e] = cb[c]; }
    const int nit = ntok / 64;
    u32x4 zr[6];
#define MC_LOADZ(item) do { const int _tok0 = gtok(grp.g, (item) * 64); int _s0, _len; if (_tok0 < NLAT) { _s0 = _tok0 & ~2047; _len = 2048; } else { _s0 = NLAT + ((_tok0 - NLAT) & ~255); _len = 256; } \
        _Pragma("unroll") for (int k = 0; k < 6; ++k) { const int idx = tid + 512 * k, r = idx >> 5, c8 = (idx & 31) * 8, pos = _tok0 - _s0 - 15 + r; zr[k] = (u32x4){0u, 0u, 0u, 0u}; \
            if (idx < 94 * 32 && pos >= 0 && pos < _len) zr[k] = *(const u32x4*)(P + (size_t)(_s0 + pos) * DINP + 1280 + c8); } } while (0)
    for (int item = G - 1 - vcu; item < nit; item += G) {
        const int tok0 = gtok(grp.g, item * 64);
        MC_LOADZ(item);
        __syncthreads();
#pragma unroll
        for (int k = 0; k < 6; ++k) { const int idx = tid + 512 * k, r = idx >> 5, c8 = (idx & 31) * 8;
            if (idx < 94 * 32) { const u32x4 zz = zr[k];
                *(LAS f32x4*)(zs + r * 256 + c8) = (f32x4){blo(zz.x), bhi(zz.x), blo(zz.y), bhi(zz.y)}; *(LAS f32x4*)(zs + r * 256 + c8 + 4) = (f32x4){blo(zz.z), bhi(zz.z), blo(zz.w), bhi(zz.w)}; } }
        __syncthreads();
        float res[8][4];
#pragma unroll
        for (int hp = 0; hp < 2; ++hp) {
            const int c = hp * 128 + 2 * lane;
            float w0[31], w1[31];
#pragma unroll
            for (int j = 0; j < 31; ++j) { const f32x2 w = *(const LAS f32x2*)(wl + j * 256 + c); w0[j] = w.x; w1[j] = w.y; }
            float a0[8], a1[8];
#pragma unroll
            for (int r = 0; r < 8; ++r) { a0[r] = cbv[2 * hp]; a1[r] = cbv[2 * hp + 1]; }
#pragma unroll
            for (int rr = 0; rr < 38; ++rr) {
                const f32x2 z = *(const LAS f32x2*)(zs + (8 * wave + rr) * 256 + c);
#pragma unroll
                for (int r = 0; r < 8; ++r) { const int j = rr - r; if (j >= 0 && j < 31) { a0[r] += z.x * w0[j]; a1[r] += z.y * w1[j]; } }
            }
#pragma unroll
            for (int r = 0; r < 8; ++r) { res[r][2 * hp] = a0[r]; res[r][2 * hp + 1] = a1[r]; }
        }
#pragma unroll
        for (int r = 0; r < 8; ++r) {
            const float mean = wave_sum(res[r][0] + res[r][1] + res[r][2] + res[r][3]) * (1.f / 256.f);
            const float d0 = res[r][0] - mean, d1 = res[r][1] - mean, d2 = res[r][2] - mean, d3 = res[r][3] - mean;
            const float rstd = rsqrtf(wave_sum(d0 * d0 + d1 * d1 + d2 * d2 + d3 * d3) * (1.f / 256.f) + EPS);
            const int tok = tok0 + 8 * wave + r;
            *(unsigned*)(Y + (size_t)tok * D + 512 + 2 * lane) = pk2(silu_f(d0 * rstd * gv[0] + bv[0]), silu_f(d1 * rstd * gv[1] + bv[1]));
            *(unsigned*)(Y + (size_t)tok * D + 512 + 128 + 2 * lane) = pk2(silu_f(d2 * rstd * gv[2] + bv[2]), silu_f(d3 * rstd * gv[3] + bv[3]));
        }
    }
#undef MC_LOADZ
    __syncthreads();
}

__device__ __forceinline__ void ph_mix_d(int l, int ntok, const Args& a, const Grp grp) {
    const bf16* P = (const bf16*)(a.ws + WS_P); bf16* Y = (bf16*)(a.ws + WS_Y); const float* dw = a.in[23] + l * 3 * 256;
    int tid_ = MK_TID(grp); asm volatile("" : "+v"(tid_));
    const int c8 = (tid_ & 31) * 8, rid = grp.v * 16 + (tid_ >> 5), nruns = grp.n * 16;
    constexpr int CH = 9;
    const int R = (ntok + nruns - 1) / nruns, t0 = rid * R, t1 = (t0 + R < ntok) ? t0 + R : ntok;
    f32x4 wa[3], wb[3];
#pragma unroll
    for (int j = 0; j < 3; ++j) { wa[j] = *(const f32x4*)(dw + j * 256 + c8); wb[j] = *(const f32x4*)(dw + j * 256 + c8 + 4); }
    for (int tc = t0; tc < t1; tc += CH) {
        u32x4 dd[CH + 2], db[CH];
#pragma unroll
        for (int i = 0; i < CH + 2; ++i) { int t = tc - 1 + i; t = t < 0 ? 0 : (t >= ntok ? ntok - 1 : t); dd[i] = *(const u32x4*)(P + (size_t)gtok(grp.g, t) * DINP + 1792 + c8); }
#pragma unroll
        for (int i = 0; i < CH; ++i) { int t = tc + i; t = t >= ntok ? ntok - 1 : t; db[i] = *(const u32x4*)(P + (size_t)gtok(grp.g, t) * DINP + 1536 + c8); }
#pragma unroll
        for (int i = 0; i < CH; ++i) {
            const int t = tc + i;
            if (t < t1) {
                const int tok = gtok(grp.g, t);
                int s0, len; if (tok < NLAT) { s0 = tok & ~2047; len = 2048; } else { s0 = NLAT + ((tok - NLAT) & ~255); len = 256; }
                const int pos = tok - s0;
                float acc[8];
#pragma unroll
                for (int k = 0; k < 8; ++k) acc[k] = 0.f;
#pragma unroll
                for (int j = 0; j < 3; ++j) { const int pp = pos + j - 1;
                    if (pp >= 0 && pp < len) { const u32x4 d = dd[i + j];
                        acc[0] += blo(d.x) * wa[j].x; acc[1] += bhi(d.x) * wa[j].y; acc[2] += blo(d.y) * wa[j].z; acc[3] += bhi(d.y) * wa[j].w;
                        acc[4] += blo(d.z) * wb[j].x; acc[5] += bhi(d.z) * wb[j].y; acc[6] += blo(d.w) * wb[j].z; acc[7] += bhi(d.w) * wb[j].w; } }
                const u32x4 b = db[i];
                u32x4 o; o.x = pk2(blo(b.x) * acc[0], bhi(b.x) * acc[1]); o.y = pk2(blo(b.y) * acc[2], bhi(b.y) * acc[3]); o.z = pk2(blo(b.z) * acc[4], bhi(b.z) * acc[5]); o.w = pk2(blo(b.w) * acc[6], bhi(b.w) * acc[7]);
                *(u32x4*)(Y + (size_t)tok * D + 768 + c8) = o;
            }
        }
    }
}

__device__ __forceinline__ void ph_attn(LAS unsigned char* lds, int l, const Args& a, const Grp grp) {
    int tid_ = MK_TID(grp); asm volatile("" : "+v"(tid_)); const int tid = tid_, wid = __builtin_amdgcn_readfirstlane(tid >> 6), lane = tid & 63, fr = lane & 15, fq = lane >> 4, G = grp.n, vcu = grp.v;
    const bf16* P = (const bf16*)(a.ws + WS_P); bf16* Y = (bf16*)(a.ws + WS_Y);
    const float* subln = a.in[18] + l * 64;
    const float lam_init = lam_init_of(l);
    float lam, negM[2];
    { const float d1 = lane < 32 ? a.in[14][l * 32 + lane] * a.in[15][l * 32 + lane] : 0.f, d2 = lane < 32 ? a.in[16][l * 32 + lane] * a.in[17][l * 32 + lane] : 0.f;
      lam = __expf(wave_sum(d1)) - __expf(wave_sum(d2)) + lam_init;
#pragma unroll
      for (int m = 0; m < 2; ++m) { const float mq = wave_max(lane < 32 ? fabsf(a.in[12][l * 64 + m * 32 + lane]) : 0.f), mk = wave_max(lane < 32 ? fabsf(a.in[13][l * 64 + m * 32 + lane]) : 0.f); negM[m] = -8.2433f * mq * mk; } }
    const int nunits = (l == 0) ? 256 + 32 : 256;
    const int prow = (wid * 64 + lane) >> 3, pch = (lane & 7) ^ (prow & 7);
    const int rdsw = fr & 7;
    const int vch = (lane & 7) ^ (2 * ((prow >> 1) & 3));
    const int vq = fr >> 2, vp = fr & 3, vsw = 2 * (2 * (fq & 1) + (vq >> 1));
    const int vrd0 = (4 * fq + vq) * 128 + 8 * (vp & 1);
    if (wid >= 4) __builtin_amdgcn_s_setprio(1);
    for (int u = vcu; u < nunits; u += G) {
        int b, h, qtok0, t0, nt;
        if (u < 256) { b = grp.g * 8 + (u >> 5); h = (u >> 3) & 3; qtok0 = b * 2048 + (u & 7) * 256; t0 = 0; nt = 36; }
        else { const int uc = u - 256; b = grp.g * 8 + (uc >> 2); h = uc & 3; qtok0 = NLAT + b * 256; t0 = 32; nt = 4; }
        bf16x8_t Qf[2][2];
#pragma unroll
        for (int m = 0; m < 2; ++m)
#pragma unroll
            for (int qb = 0; qb < 2; ++qb) Qf[m][qb] = *(const bf16x8_t*)(P + (size_t)(qtok0 + wid * 32 + qb * 16 + fr) * DINP + 512 + h * 64 + m * 32 + 8 * fq);
        f32x4 O[2][4][2], Ls[2][2];
        const bf16x8_t ones = __builtin_bit_cast(bf16x8_t, (u32x4){0x3f803f80u, 0x3f803f80u, 0x3f803f80u, 0x3f803f80u});
#pragma unroll
        for (int m = 0; m < 2; ++m)
#pragma unroll
            for (int qb = 0; qb < 2; ++qb) { Ls[m][qb] = (f32x4){0.f, 0.f, 0.f, 0.f};
#pragma unroll
                for (int eb = 0; eb < 4; ++eb) O[m][eb][qb] = (f32x4){0.f, 0.f, 0.f, 0.f}; }
#define ATT_ISSUE(j) do { const int _t = t0 + (j); const int _kt = _t < 32 ? b * 2048 + _t * 64 : NLAT + b * 256 + (_t - 32) * 64; const int _s = (j) % 3; \
        __builtin_amdgcn_global_load_lds((const unsigned*)(P + (size_t)(_kt + prow) * DINP + 768 + h * 64 + pch * 8), (LAS unsigned*)(lds + _s * 16384 + wid * 1024), 16, 0, 0); \
        __builtin_amdgcn_global_load_lds((const unsigned*)(P + (size_t)(_kt + prow) * DINP + 1024 + h * 64 + vch * 8), (LAS unsigned*)(lds + _s * 16384 + 8192 + wid * 1024), 16, 0, 0); } while (0)
        asm volatile("s_waitcnt lgkmcnt(0)\n\ts_barrier" ::: "memory");
        ATT_ISSUE(0); ATT_ISSUE(1);
        for (int i = 0; i < nt; ++i) {
            if (i + 1 < nt) asm volatile("s_waitcnt vmcnt(2)\n\ts_barrier" ::: "memory"); else asm volatile("s_waitcnt vmcnt(0)\n\ts_barrier" ::: "memory");
            if (i + 2 < nt) ATT_ISSUE(i + 2);
            const LAS unsigned char* Ks = lds + (i % 3) * 16384; const LAS unsigned char* Vs = Ks + 8192;
            bf16x8_t Pf[2][2][2];
#pragma unroll
            for (int m = 0; m < 2; ++m) {
                f32x4 S[4][2];
#pragma unroll
                for (int kb = 0; kb < 4; ++kb) {
                    const bf16x8_t kf = *(const LAS bf16x8_t*)(Ks + (16 * kb + fr) * 128 + (((m * 4 + fq) ^ rdsw) * 16));
#pragma unroll
                    for (int qb = 0; qb < 2; ++qb) S[kb][qb] = __builtin_amdgcn_mfma_f32_16x16x32_bf16(kf, Qf[m][qb], (f32x4){negM[m], negM[m], negM[m], negM[m]}, 0, 0, 0);
                }
#pragma unroll
                for (int qb = 0; qb < 2; ++qb) {
#pragma unroll
                    for (int kb = 0; kb < 4; ++kb) {
#pragma unroll
                        for (int j = 0; j < 4; ++j) S[kb][qb][j] = __builtin_amdgcn_exp2f(S[kb][qb][j]); }
#pragma unroll
                    for (int g = 0; g < 2; ++g) { u32x4 w; w.x = pg8::cvt_pk_bf16(S[2 * g][qb][0], S[2 * g][qb][1]); w.y = pg8::cvt_pk_bf16(S[2 * g][qb][2], S[2 * g][qb][3]);
                        w.z = pg8::cvt_pk_bf16(S[2 * g + 1][qb][0], S[2 * g + 1][qb][1]); w.w = pg8::cvt_pk_bf16(S[2 * g + 1][qb][2], S[2 * g + 1][qb][3]); Pf[m][g][qb] = __builtin_bit_cast(bf16x8_t, w);
                        Ls[m][qb] = __builtin_amdgcn_mfma_f32_16x16x32_bf16(ones, Pf[m][g][qb], Ls[m][qb], 0, 0, 0); }
                }
            }
#pragma unroll
            for (int eb = 0; eb < 4; ++eb)
#pragma unroll
                for (int g = 0; g < 2; ++g) {
                    const int vslot = ((2 * eb + (vp >> 1)) ^ vsw) * 16;
                    const v4i16_t t0 = __builtin_amdgcn_ds_read_tr16_b64_v4i16((LAS v4i16_t*)(Vs + (32 * g) * 128 + vrd0 + vslot)), t1 = __builtin_amdgcn_ds_read_tr16_b64_v4i16((LAS v4i16_t*)(Vs + (32 * g + 16) * 128 + vrd0 + vslot));
                    const bf16x8_t vf = __builtin_shufflevector(t0, t1, 0, 1, 2, 3, 4, 5, 6, 7);
#pragma unroll
                    for (int m = 0; m < 2; ++m)
#pragma unroll
                        for (int qb = 0; qb < 2; ++qb) O[m][eb][qb] = __builtin_amdgcn_mfma_f32_16x16x32_bf16(vf, Pf[m][g][qb], O[m][eb][qb], 0, 0, 0);
                }
        }
#undef ATT_ISSUE
#pragma unroll
        for (int qb = 0; qb < 2; ++qb) {
            const float l1 = Ls[0][qb][0], l2 = Ls[1][qb][0];
            const float r1 = 1.f / l1, r2 = lam / l2;
            f32x4 o[4]; float ss = 0.f;
#pragma unroll
            for (int eb = 0; eb < 4; ++eb) { o[eb] = O[0][eb][qb] * r1 - O[1][eb][qb] * r2; ss += o[eb][0] * o[eb][0] + o[eb][1] * o[eb][1] + o[eb][2] * o[eb][2] + o[eb][3] * o[eb][3]; }
            ss += __shfl_xor(ss, 16); ss += __shfl_xor(ss, 32);
            const float rs = rsqrtf(ss * (1.f / 64.f) + EPS) * (1.f - lam_init);
            bf16* yp = Y + (size_t)(qtok0 + wid * 32 + qb * 16 + fr) * D + 256 + h * 64 + 4 * fq;
#pragma unroll
            for (int eb = 0; eb < 4; ++eb) { const f32x4 g = *(const f32x4*)(subln + 16 * eb + 4 * fq); u32x2 w; w.x = pk2(o[eb][0] * rs * g.x, o[eb][1] * rs * g.y); w.y = pk2(o[eb][2] * rs * g.z, o[eb][3] * rs * g.w);
                *(u32x2*)(yp + 16 * eb) = w; }
        }
    }
    __builtin_amdgcn_s_setprio(0);
    asm volatile("s_waitcnt vmcnt(0) lgkmcnt(0)\n\ts_barrier" ::: "memory");
}

constexpr int RW_PITCH = 2064, RW_PART = NE * RW_PITCH, RW_IMG = 2 * RW_PART;
__device__ __forceinline__ void ph_route(LAS unsigned char* lds, int l, int ntok, const Args& a, const Grp grp) {
    int tid_ = MK_TID(grp); asm volatile("" : "+v"(tid_)); const int tid = tid_, wave = __builtin_amdgcn_readfirstlane(tid >> 6), lane = tid & 63, fr = lane & 15, fq = lane >> 4, G = grp.n, vcu = grp.v;
    const bf16* X = (const bf16*)(a.ws + WS_X); const float* mod = (const float*)(a.ws + WS_MOD); const float* norm_g = a.in[7] + l * D; const float* rb = a.in[26] + l * NE;
    unsigned char* H8 = a.ws + WS_H8; unsigned* cnt = (unsigned*)(a.ws + WS_CTL) + CW_CNT + (grp.g * NL + l) * 64; int* list = (int*)(a.ws + WS_LIST) + (size_t)grp.g * NE * GCAP; float* gate = (float*)(a.ws + WS_GATE);
    const float* SSp = (const float*)(a.ws + WS_SS);
    LAS unsigned* hist = (LAS unsigned*)(lds + LDS_MISC + 4096); LAS unsigned* gbase = hist + NE;
    LAS unsigned short* sel_e = (LAS unsigned short*)(lds + LDS_MISC + 4352); LAS unsigned short* sel_p = sel_e + 1024;
    __syncthreads();
    if (tid < NE) hist[tid] = 0u;
    for (int i = tid; i < 1024; i += 512) sel_e[i] = 0xffffu;
    const int nitems = ntok / 16, ipw = (nitems + G - 1) / G, it0 = vcu * ipw, it1 = (it0 + ipw < nitems) ? it0 + ipw : nitems;
    const int kcol = 128 * wave + 8 * fq;
    bf16x8_t wh[2][4], wl[2][4];
    { const unsigned char* img = a.ws + WS_RWT + (size_t)l * RW_IMG;
#pragma unroll
      for (int nb = 0; nb < 2; ++nb)
#pragma unroll
          for (int ks = 0; ks < 4; ++ks) { const unsigned char* wp = img + (nb * 16 + fr) * RW_PITCH + (kcol + 32 * ks) * 2; wh[nb][ks] = *(const bf16x8_t*)wp; wl[nb][ks] = *(const bf16x8_t*)(wp + RW_PART); } }
    f32x4 ca[4][2], cb[4][2]; int cmr = -1;
    u32x4 xw[4], xn[4]; f32x4 p4, pn4;
#define RT_LOAD(xv, pv, it) do { const int _tok = gtok(grp.g, (it) * 16) + fr; const bf16* _xr = X + (size_t)_tok * D + kcol; \
        _Pragma("unroll") for (int ks = 0; ks < 4; ++ks) xv[ks] = *(const u32x4*)(_xr + 32 * ks); pv = *(const f32x4*)(SSp + (size_t)_tok * 16 + 4 * fq); } while (0)
    if (it0 < it1) RT_LOAD(xw, p4, it0);
    for (int ib = it0; ib < it1; ib += 5) {
        const int ni = (it1 - ib < 5) ? it1 - ib : 5;
        for (int s = 0; s < ni; ++s) {
            const int it = ib + s, tb0 = gtok(grp.g, it * 16), tok = tb0 + fr, mr = tok_modrow(tb0);
            if (it + 1 < it1) RT_LOAD(xn, pn4, it + 1);
            if (mr != cmr) { cmr = mr; const float* mrow = mod + ((size_t)l * 17 + mr) * MODW + kcol; const float* gp = norm_g + kcol;
#pragma unroll
                for (int ks = 0; ks < 4; ++ks)
#pragma unroll
                    for (int hf = 0; hf < 2; ++hf) { const f32x4 g = *(const f32x4*)(gp + 32 * ks + 4 * hf), sh = *(const f32x4*)(mrow + 3 * D + 32 * ks + 4 * hf), sc = *(const f32x4*)(mrow + 4 * D + 32 * ks + 4 * hf);
                        ca[ks][hf] = g * (1.f + sc); cb[ks][hf] = sh; } }
            float ss = (p4.x + p4.y) + (p4.z + p4.w);
            ss += __shfl_xor(ss, 16); ss += __shfl_xor(ss, 32);
            const float rstd = rsqrtf(ss * (1.f / D) + EPS);
            f32x4 acc[2] = {{0.f, 0.f, 0.f, 0.f}, {0.f, 0.f, 0.f, 0.f}};
#pragma unroll
            for (int ks = 0; ks < 4; ++ks) {
                float h[8];
                { const u32x4 w = xw[ks]; const f32x4 x0 = {blo(w.x), bhi(w.x), blo(w.y), bhi(w.y)}, x1 = {blo(w.z), bhi(w.z), blo(w.w), bhi(w.w)};
                  const f32x4 h0 = x0 * rstd * ca[ks][0] + cb[ks][0], h1 = x1 * rstd * ca[ks][1] + cb[ks][1];
                  h[0] = h0.x; h[1] = h0.y; h[2] = h0.z; h[3] = h0.w; h[4] = h1.x; h[5] = h1.y; h[6] = h1.z; h[7] = h1.w; }
                u32x2 w8; { int t = __builtin_amdgcn_cvt_pk_fp8_f32(h[0], h[1], 0, false); t = __builtin_amdgcn_cvt_pk_fp8_f32(h[2], h[3], t, true); w8.x = (unsigned)t;
                            t = __builtin_amdgcn_cvt_pk_fp8_f32(h[4], h[5], 0, false); t = __builtin_amdgcn_cvt_pk_fp8_f32(h[6], h[7], t, true); w8.y = (unsigned)t; }
                *(u32x2*)(H8 + (size_t)tok * D + kcol + 32 * ks) = w8;
                u32x4 hh, hl;
                hh.x = pg8::cvt_pk_bf16(h[0], h[1]); hh.y = pg8::cvt_pk_bf16(h[2], h[3]); hh.z = pg8::cvt_pk_bf16(h[4], h[5]); hh.w = pg8::cvt_pk_bf16(h[6], h[7]);
                hl.x = pg8::cvt_pk_bf16(h[0] - blo(hh.x), h[1] - bhi(hh.x)); hl.y = pg8::cvt_pk_bf16(h[2] - blo(hh.y), h[3] - bhi(hh.y)); hl.z = pg8::cvt_pk_bf16(h[4] - blo(hh.z), h[5] - bhi(hh.z)); hl.w = pg8::cvt_pk_bf16(h[6] - blo(hh.w), h[7] - bhi(hh.w));
                const bf16x8_t fh = __builtin_bit_cast(bf16x8_t, hh), fl = __builtin_bit_cast(bf16x8_t, hl);
#pragma unroll
                for (int nb = 0; nb < 2; ++nb) {
                    acc[nb] = __builtin_amdgcn_mfma_f32_16x16x32_bf16(wh[nb][ks], fh, acc[nb], 0, 0, 0);
                    acc[nb] = __builtin_amdgcn_mfma_f32_16x16x32_bf16(wh[nb][ks], fl, acc[nb], 0, 0, 0);
                    acc[nb] = __builtin_amdgcn_mfma_f32_16x16x32_bf16(wl[nb][ks], fh, acc[nb], 0, 0, 0);
                }
            }
#pragma unroll
            for (int nb = 0; nb < 2; ++nb) *(LAS f32x4*)(lds + ((s * 8 + wave) * 2 + nb) * 1024 + lane * 16) = acc[nb];
#pragma unroll
            for (int ks = 0; ks < 4; ++ks) xw[ks] = xn[ks];
            p4 = pn4;
        }
        __syncthreads();
        if (wave < ni) {
            const int it = ib + wave, tok = gtok(grp.g, it * 16) + fr;
            float lg[8];
#pragma unroll
            for (int nb = 0; nb < 2; ++nb) { f32x4 sum = *(const f32x4*)(rb + 16 * nb + 4 * fq);
#pragma unroll
                for (int w = 0; w < 8; ++w) sum += *(const LAS f32x4*)(lds + ((wave * 8 + w) * 2 + nb) * 1024 + lane * 16);
#pragma unroll
                for (int jj = 0; jj < 4; ++jj) lg[4 * nb + jj] = sum[jj]; }
            float tv[4]; int ti[4];
#pragma unroll
            for (int k = 0; k < 4; ++k) {
                float bv = lg[0]; int bi = 4 * fq;
#pragma unroll
                for (int q = 1; q < 8; ++q) { const int eq = 16 * (q >> 2) + 4 * fq + (q & 3); if (lg[q] > bv) { bv = lg[q]; bi = eq; } }
#pragma unroll
                for (int o = 16; o < 64; o <<= 1) { const float ov = __shfl_xor(bv, o); const int oi = __shfl_xor(bi, o); if (ov > bv || (ov == bv && oi < bi)) { bv = ov; bi = oi; } }
                tv[k] = bv; ti[k] = bi;
#pragma unroll
                for (int q = 0; q < 8; ++q) { const int eq = 16 * (q >> 2) + 4 * fq + (q & 3); if (eq == bi) lg[q] = -3.0e38f; }
            }
            if (fq == 0) {
                const float e1 = __expf(tv[1] - tv[0]), e2 = __expf(tv[2] - tv[0]), e3 = __expf(tv[3] - tv[0]); const float rz = 1.f / (1.f + e1 + e2 + e3);
                *(f32x4*)(gate + (size_t)tok * 4) = (f32x4){rz, e1 * rz, e2 * rz, e3 * rz};
                const int lt = (it - it0) * 16 + fr;
#pragma unroll
                for (int k = 0; k < 4; ++k) { const unsigned lp = __hip_atomic_fetch_add(&hist[ti[k]], 1u, __ATOMIC_RELAXED, __HIP_MEMORY_SCOPE_WORKGROUP); sel_e[lt * 4 + k] = (unsigned short)ti[k]; sel_p[lt * 4 + k] = (unsigned short)lp; }
            }
        }
        __syncthreads();
    }
#undef RT_LOAD
    if (tid < NE) gbase[tid] = __hip_atomic_fetch_add(&cnt[tid], hist[tid], __ATOMIC_RELAXED, __HIP_MEMORY_SCOPE_AGENT);
    __syncthreads();
    for (int i = tid; i < 1024; i += 512) { const int ee = sel_e[i];
        if (ee != 0xffff) { const int lt = i >> 2, tk = gtok(grp.g, (it0 + (lt >> 4)) * 16) + (lt & 15); list[(size_t)ee * GCAP + gbase[ee] + sel_p[i]] = tk * 4 + (i & 3); } }
    __syncthreads();
}

__device__ __forceinline__ void group_tables(LAS int* misc, const unsigned* cnt, const Grp grp) {
    __syncthreads();
    int tid_ = MK_TID(grp); asm volatile("" : "+v"(tid_));
    if (tid_ < 32) misc[64 + tid_] = (int)__hip_atomic_load(cnt + tid_, __ATOMIC_RELAXED, __HIP_MEMORY_SCOPE_AGENT);
    __syncthreads();
    if (tid_ == 0) { int s = 0; for (int e = 0; e < 32; ++e) { misc[e] = s; s += (misc[64 + e] + 255) >> 8; } misc[32] = s; }
    __syncthreads();
}

constexpr int N_PHASES = 2 + 7 * NL;
__global__ void __launch_bounds__(512, 2) mk_fwd(Args a) {
    extern __shared__ __attribute__((aligned(16))) unsigned char lds_raw[];
    LAS unsigned char* lds = (LAS unsigned char*)lds_raw;
    LAS int* misc = (LAS int*)(lds + LDS_MISC);
    const int wv_ = __builtin_amdgcn_readfirstlane((int)threadIdx.x >> 6), G = gridDim.x, bx = blockIdx.x;
#define tid (wv_ * 64 + mk_lane())
    const int vcu = (G % 8 == 0) ? (bx % 8) * (G / 8) + bx / 8 : bx;
    Grp grp;
    if (G % 16 == 0) { grp.g = (bx >> 3) & 1; grp.v = (bx & 7) * (G / 16) + (bx >> 4); grp.c = (bx & 7) + 8 * (bx >> 4); } else { grp.g = bx & 1; grp.v = bx >> 1; grp.c = bx >> 1; }
    grp.n = G / 2; grp.w = wv_;
    if (tid < 4) misc[128 + tid] = 0;
    __syncthreads();
    unsigned* flags = (unsigned*)(a.ws + WS_CTL) + CW_FLAG;
#if MK_PER_PHASE
#define GRID_BAR() do { } while (0)
#define WAIT_FLAG(w) do { } while (0)
#define SET_FLAG(w) do { } while (0)
#else
    XcdBarrier bar = xcd_barrier_post((unsigned*)(a.ws + WS_CTL) + CW_BAR + grp.g * XCD_BAR_WORDS, (volatile LAS unsigned*)(misc + 128), (unsigned)grp.n, (unsigned)wv_);
#define GRID_BAR() xcd_barrier(bar)
#define SET_FLAG(w) do { if (grp.v == 0 && tid == 0) __hip_atomic_store(flags + 64 * (w), 1u, __ATOMIC_RELAXED, __HIP_MEMORY_SCOPE_AGENT); } while (0)
#define WAIT_FLAG(w) do { if (tid == 0) { unsigned sp_ = 0; while (__hip_atomic_load(flags + 64 * (w), __ATOMIC_RELAXED, __HIP_MEMORY_SCOPE_AGENT) == 0u) { __builtin_amdgcn_s_sleep(8); if (++sp_ > (1u << 22)) break; } \
        __builtin_amdgcn_fence(__ATOMIC_ACQUIRE, "agent"); asm volatile("s_waitcnt vmcnt(0)" ::: "memory"); } __syncthreads(); } while (0)
#endif
    const int lo = a.ph_lo, hi = a.ph_hi;
#ifndef PH_MASK
#define PH_MASK 0x3ff
#endif
#define PHM(j) (((PH_MASK) >> (j)) & 1)
#define IN(k) (lo <= (k) && (k) < hi)
#define SEAM(k) do { if ((k) + 1 < hi) GRID_BAR(); } while (0)
    unsigned char* ws = a.ws;
    bf16* H = (bf16*)(ws + WS_H); bf16* P = (bf16*)(ws + WS_P); bf16* Y = (bf16*)(ws + WS_Y); unsigned char* O8 = ws + WS_O; bf16* X = (bf16*)(ws + WS_X);
    unsigned char* HID8 = ws + WS_HID + (size_t)grp.g * GHIDROWS * FF;
    const float* MOD = (const float*)(ws + WS_MOD); const int* LISTG = (const int*)(ws + WS_LIST) + (size_t)grp.g * NE * GCAP;

    if (PHM(0) && IN(0)) {
        constexpr long L0_ITEMS = (long)NE * ((D / 128) * (2 * FF / 32) + (FF / 128) * (D / 32)), L0_SPLIT = L0_ITEMS / 2;
        if (grp.g == 0) { ph_prologue(lds, a, grp, 0); if (1 < hi) { GRID_BAR(); SET_FLAG(0); } ph_prologue(lds, a, grp, 1, L0_SPLIT, L0_ITEMS); if (1 < hi) { GRID_BAR(); SET_FLAG(1); WAIT_FLAG(3); } }
        else { ph_prologue(lds, a, grp, 3); ph_prologue(lds, a, grp, 1, 0, L0_SPLIT); if (1 < hi) { GRID_BAR(); SET_FLAG(3); WAIT_FLAG(0); } }
#if MK_PER_PHASE
        if (grp.g == 1) ph_prologue(lds, a, grp, 2);
#endif
    }
    constexpr long L1_EARLY2 = (G1_QHI < 10 && !G1_FP8) ? 1280 : 0;
    constexpr long L1_EARLY = 3072;
    for (int l = 0; l < NL; ++l) {
        const int base = 1 + 7 * l, ntok = l == 0 ? GTOK : GLAT;
        const unsigned* cnt = (const unsigned*)(ws + WS_CTL) + CW_CNT + (grp.g * NL + l) * 64;
        if (PHM(1) && IN(base + 0)) { ph_norm1(l, a, grp); SEAM(base + 0); }
        if (PHM(2) && IN(base + 1)) {
#if G1_FP8
            pg8::DenseOrder S; S.init(H, (const bf16*)(ws + WS_WIN + (size_t)l * DIN * D), GTOK, DIN, D / 2, grp.n, grp.c, grp.g);
            pg8::gemm_phase<pg8::EpiP, pg8::DenseOrder, false, true>(lds, D / 2, S, pg8::EpiP{P, a.in[12] + l * 64, (long)(a.in[13] - a.in[12])}, grp.w);
#else
            if (G1_QLO > 0) { pg8::DenseOrder S; S.init(H, (const bf16*)(ws + WS_WIN) + (size_t)l * DIN * D, GTOK, G1_QLO * 256, D, grp.n, grp.c, grp.g);
              pg8::gemm_phase<pg8::EpiPT<false, 0>, pg8::DenseOrder, false>(lds, D, S, pg8::EpiPT<false, 0>{P, a.in[12] + l * 64, (long)(a.in[13] - a.in[12])}, grp.w); }
            if (DINQ > 0) { pg8::DenseOrder S; S.init((const bf16*)(ws + WS_HQ), (const bf16*)(ws + WS_WINQ + (size_t)l * DINQ * D), GTOK, DINQ, D / 2, grp.n, grp.c, grp.g);
              pg8::gemm_phase<pg8::EpiPT<true, G1_QLO>, pg8::DenseOrder, false, true>(lds, D / 2, S, pg8::EpiPT<true, G1_QLO>{P, a.in[12] + l * 64, (long)(a.in[13] - a.in[12])}, grp.w); }
            if (G1_QHI < 10) { pg8::DenseOrder S; S.init(H, (const bf16*)(ws + WS_WIN) + (size_t)l * DIN * D + (size_t)G1_QHI * 256 * D, GTOK, (10 - G1_QHI) * 256, D, grp.n, grp.c, grp.g);
              pg8::gemm_phase<pg8::EpiPT<false, G1_QHI>, pg8::DenseOrder, false>(lds, D, S, pg8::EpiPT<false, G1_QHI>{P, a.in[12] + l * 64, (long)(a.in[13] - a.in[12])}, grp.w); }
#endif
#if !MK_PER_PHASE && !G1_FP8
            if (l == 1 && lo == 0 && G1_QHI < 10) { const int nun = (GTOK / 256) * (10 - G1_QHI), busy = nun % grp.n;
                if (busy != 0 && grp.c >= busy) { Grp gq = grp; gq.v = grp.c - busy; gq.n = grp.n - busy; __syncthreads(); ph_prologue(lds, a, gq, 2, 2 * L1_EARLY + (long)grp.g * L1_EARLY2, 2 * L1_EARLY + (long)(grp.g + 1) * L1_EARLY2); } }
#endif
            SEAM(base + 1);
#if !MK_PER_PHASE && !G1_FP8
            if (l == 1 && lo == 0 && G1_QHI < 10) SET_FLAG(5 + grp.g);
#endif
        }
        if (PHM(3) && IN(base + 2)) { ph_attn(lds, l, a, grp); ph_mix_a(lds, l, ntok, a, grp); ph_mix_c(lds, l, ntok, a, grp); ph_mix_d(l, ntok, a, grp); SEAM(base + 2); }
        if (PHM(5) && IN(base + 3)) {
            pg8::DenseOrder S; S.init(Y, (const bf16*)(ws + WS_WOUT) + (size_t)l * D * D, ntok, D, D, grp.n, grp.c, grp.g);
            pg8::gemm_phase<pg8::EpiX, pg8::DenseOrder, false>(lds, D, S, pg8::EpiX{X, l == 0 ? (const void*)a.in[0] : (const void*)X, l == 0 ? (const void*)a.in[2] : (const void*)(X + (size_t)NLAT * D), MOD + (size_t)l * 17 * MODW + 2 * D, (float*)(ws + WS_SS), l == 0 ? 1 : 0}, grp.w);
#if !MK_PER_PHASE
            if (l == 0 && lo == 0) { const int nun = (ntok / 256) * (D / 256), busy = nun % grp.n;
                if (busy != 0 && grp.c >= busy) { Grp gq = grp; gq.v = grp.c - busy; gq.n = grp.n - busy; __syncthreads(); ph_prologue(lds, a, gq, 2, (long)grp.g * L1_EARLY, (long)(grp.g + 1) * L1_EARLY); } }
#endif
            SEAM(base + 3);
#if !MK_PER_PHASE
            if (l == 0 && lo == 0 && grp.g == 0) SET_FLAG(4);
#endif
        }
        if (PHM(6) && IN(base + 4)) { ph_route(lds, l, ntok, a, grp); SEAM(base + 4); }
        if (PHM(7) && IN(base + 5)) {
            if (lo == 0) { if (l == 0 && grp.g == 1) WAIT_FLAG(1); if (l == 1 && grp.g == 0) { WAIT_FLAG(2); WAIT_FLAG(6); } if (l == 1 && grp.g == 1) { WAIT_FLAG(4); WAIT_FLAG(5); } }
            group_tables(misc, cnt, grp);
            pg8::GroupOrder S{misc, misc + 64, (const char*)(ws + WS_H8), (const char*)(ws + WS_WGU) + (size_t)l * NE * 2 * FF * D, LISTG, (size_t)2 * FF * D, D / 2, 8, grp.n, grp.v, true};
            pg8::gemm_phase<pg8::EpiHid, pg8::GroupOrder, true, true>(lds, D / 2, S, pg8::EpiHid{(bf16*)HID8, a.in[28] + (size_t)l * NE * 2 * FF, misc}, grp.w, misc + 256);
            SEAM(base + 5);
        }
        if (PHM(8) && IN(base + 6)) {
            group_tables(misc, cnt, grp);
            pg8::GroupOrder S{misc, misc + 64, (const char*)HID8, (const char*)(ws + WS_WDN) + (size_t)l * NE * D * FF, LISTG, (size_t)D * FF, FF / 2, 4, grp.n, grp.v, false};
            pg8::gemm_phase<pg8::EpiO, pg8::GroupOrder, false, true>(lds, FF / 2, S, pg8::EpiO{O8, a.in[30] + (size_t)l * NE * D}, grp.w, misc + 256);
#if !MK_PER_PHASE
            if (l == 0 && grp.g == 1 && lo == 0) { __syncthreads(); ph_prologue(lds, a, grp, 2, 2 * L1_EARLY + 2 * L1_EARLY2); }
#endif
            SEAM(base + 6);
#if !MK_PER_PHASE
            if (l == 0 && grp.g == 1 && lo == 0) SET_FLAG(2);
#endif
        }
    }
    if (PHM(9) && IN(N_PHASES - 1)) ph_final(a, grp);
#undef IN
#undef SEAM
#undef GRID_BAR
#undef tid
}

extern "C" void kernel_launch(void* const* d_in, const int* in_sizes, int n_in, void* d_out, int out_size, void* d_ws, size_t ws_size, hipStream_t stream) {
    static int grid = 0;
    if (grid == 0) {
        if (n_in != 31 || ws_size < WS_END || out_size != NLAT * D) { fprintf(stderr, "kernel_launch: unexpected shapes (n_in %d, ws %zu, out %d)\n", n_in, ws_size, out_size); grid = -1; return; }
        int dev = 0, cus = 0, per_cu = 0;
        if (hipGetDevice(&dev) != hipSuccess || hipDeviceGetAttribute(&cus, hipDeviceAttributeMultiprocessorCount, dev) != hipSuccess || cus <= 0) { fprintf(stderr, "kernel_launch: device query failed\n"); grid = -1; return; }
        if (hipFuncSetAttribute((const void*)mk_fwd, hipFuncAttributeMaxDynamicSharedMemorySize, LDS_BYTES) != hipSuccess) { fprintf(stderr, "kernel_launch: hipFuncSetAttribute failed\n"); grid = -1; return; }
        if (hipOccupancyMaxActiveBlocksPerMultiprocessor(&per_cu, (const void*)mk_fwd, 512, LDS_BYTES) != hipSuccess || per_cu < 1) { fprintf(stderr, "kernel_launch: occupancy query reports %d workgroups per CU\n", per_cu); (void)hipGetLastError(); }
        grid = cus & ~15;
    }
    if (grid < 0) return;
    (void)hipMemsetAsync((unsigned char*)d_ws + WS_CTL, 0, CTL_BYTES, stream);
    Args a{};
    for (int i = 0; i < 31; ++i) a.in[i] = (const float*)d_in[i];
    a.out = (float*)d_out; a.ws = (unsigned char*)d_ws;
#if MK_PER_PHASE
    for (int p = 0; p < N_PHASES; ++p) { a.ph_lo = p; a.ph_hi = p + 1; hipLaunchKernelGGL(mk_fwd, dim3(grid), dim3(512), LDS_BYTES, stream, a); }
#else
    a.ph_lo = 0; a.ph_hi = N_PHASES;
    hipLaunchKernelGGL(mk_fwd, dim3(grid), dim3(512), LDS_BYTES, stream, a);
#endif
}
```
